# Optimizing an MI355X kernel written in HIP

```python
import math
import jax, jax.numpy as jnp
from jax import lax
import numpy as np

D_MODEL = 4096
BATCH = 2
SEQ = 4096
DEPTH = 2

CTX_LEN = 256
GRID_W = 64
D_HEAD = 128
H_DIFF = 8
DIFF_QK = 2 * D_HEAD
DIFF_V = 2 * D_HEAD
FNET_GROUPS = 8
FNET_GROUP_W = 256
H_GQA = 16
H_KV = 4
BRANCH_W = 2048
N_BRANCH = 3
D_FF = 11008
CONV_W = 3
Q_BLOCK = 128
ROPE_THETA = 10000.0
NORM_EPS = 1e-6
DEEPNORM_ALPHA = (2 * DEPTH) ** 0.25
DEEPNORM_BETA = (8 * DEPTH) ** -0.25

A_Q = H_DIFF * DIFF_QK
A_K = H_DIFF * DIFF_QK
A_V = H_DIFF * DIFF_V
B_W = FNET_GROUPS * FNET_GROUP_W
C_Q = H_GQA * D_HEAD
C_K = H_KV * D_HEAD
C_V = H_KV * D_HEAD
D_IN = A_Q + A_K + A_V + B_W + C_Q + C_K + C_V
SPLIT_POINTS = (A_Q, A_Q + A_K, A_Q + A_K + A_V, A_Q + A_K + A_V + B_W,
                A_Q + A_K + A_V + B_W + C_Q, A_Q + A_K + A_V + B_W + C_Q + C_K)

kernel_name = "hybrid_diffattn_fnet_gqa_convffn_prefix_ctx"


def layer_norm(x, g, b):
    xf = x.astype(jnp.float32)
    mu = jnp.mean(xf, axis=-1, keepdims=True)
    var = jnp.mean(jnp.square(xf - mu), axis=-1, keepdims=True)
    return ((xf - mu) * lax.rsqrt(var + NORM_EPS)).astype(x.dtype) * g + b


def rms_norm(x, g):
    xf = x.astype(jnp.float32)
    return (xf * lax.rsqrt(jnp.mean(xf * xf, axis=-1, keepdims=True) + NORM_EPS)).astype(x.dtype) * g


def axial_rope_tables(n, dtype):
    n_rows = n // GRID_W
    rows = jnp.broadcast_to(jnp.arange(n_rows)[:, None], (n_rows, GRID_W)).reshape(-1).astype(jnp.float32)
    cols = jnp.broadcast_to(jnp.arange(GRID_W)[None, :], (n_rows, GRID_W)).reshape(-1).astype(jnp.float32)
    quarter = D_HEAD // 4
    inv_freq = ROPE_THETA ** (-jnp.arange(quarter, dtype=jnp.float32) / quarter)
    ang = jnp.concatenate([rows[:, None] * inv_freq, cols[:, None] * inv_freq], axis=-1)
    ang = jnp.concatenate([ang, ang], axis=-1)[:, None, :]
    return jnp.cos(ang).astype(dtype), jnp.sin(ang).astype(dtype)


def apply_rope(x, cos, sin):
    x1, x2 = jnp.split(x, 2, axis=-1)
    return x * cos + jnp.concatenate([-x2, x1], axis=-1) * sin


def _to_blocks(q):
    b, n = q.shape[:2]
    return jnp.moveaxis(q.reshape((b, n // Q_BLOCK, Q_BLOCK) + q.shape[2:]), 1, 0)


def _from_blocks(o):
    o = jnp.moveaxis(o, 0, 1)
    return o.reshape((o.shape[0], o.shape[1] * o.shape[2]) + o.shape[3:])


def gqa_attention(q, k, v):
    b, n, h, d = q.shape
    hk = k.shape[2]
    qg = q.reshape(b, n, hk, h // hk, d)
    scale = d ** -0.5

    def block(qi):
        s = jnp.einsum('bqkgd,blkd->bkgql', qi, k).astype(jnp.float32) * scale
        p = jax.nn.softmax(s, axis=-1).astype(v.dtype)
        return jnp.einsum('bkgql,blke->bqkge', p, v)

    o = _from_blocks(lax.map(block, _to_blocks(qg)))
    return o.reshape(b, n, h * v.shape[-1])


def diff_attention(q1, q2, k1, k2, v, lam):
    scale = q1.shape[-1] ** -0.5

    def block(qs):
        qa, qb = qs
        p1 = jax.nn.softmax(jnp.einsum('bqhd,blhd->bhql', qa, k1).astype(jnp.float32) * scale, axis=-1)
        p2 = jax.nn.softmax(jnp.einsum('bqhd,blhd->bhql', qb, k2).astype(jnp.float32) * scale, axis=-1)
        p = (p1 - lam * p2).astype(v.dtype)
        return jnp.einsum('bhql,blhe->bqhe', p, v)

    return _from_blocks(lax.map(block, (_to_blocks(q1), _to_blocks(q2))))


def diff_head_norm(o, g, lam_init):
    b, n = o.shape[:2]
    return (rms_norm(o, g) * (1.0 - lam_init)).reshape(b, n, A_V)


def fourier_mix(u):
    b, n, _ = u.shape
    ug = u.reshape(b, n, FNET_GROUPS, FNET_GROUP_W).astype(jnp.float32)
    f = jnp.fft.fft2(ug, axes=(1, 3), norm='ortho').real
    return f.reshape(b, n, B_W).astype(u.dtype)


def split_proj(p):
    b, n, _ = p.shape
    aq, ak, av, bu, cq, ck, cv = jnp.split(p, SPLIT_POINTS, axis=-1)
    aq = aq.reshape(b, n, H_DIFF, 2, D_HEAD)
    ak = ak.reshape(b, n, H_DIFF, 2, D_HEAD)
    av = av.reshape(b, n, H_DIFF, DIFF_V)
    cq = cq.reshape(b, n, H_GQA, D_HEAD)
    ck = ck.reshape(b, n, H_KV, D_HEAD)
    cv = cv.reshape(b, n, H_KV, D_HEAD)
    return aq[..., 0, :], aq[..., 1, :], ak[..., 0, :], ak[..., 1, :], av, bu, cq, ck, cv


def gated_merge(h, oa, ob, oc, w_branch, w_gate, b_gate, w_o):
    br = jnp.stack([oa, ob, oc], axis=2)
    pb = jnp.einsum('bsnk,nkd->bsnd', br, w_branch)
    g = jax.nn.sigmoid(h @ w_gate + b_gate).reshape(pb.shape)
    return jnp.sum(g * pb, axis=2) @ w_o


def token_mixer(hl, hc, need_ctx_out, cos, sin, w_in, lam, lam_init, subln_g, qk_g,
                w_branch, w_gate, b_gate, w_o):
    lq1, lq2, lk1, lk2, lva, lu, lqg, lkg, lvg = split_proj(hl @ w_in)
    cq1, cq2, ck1, ck2, cva, cu, cqg, ckg, cvg = split_proj(hc @ w_in)
    lq1, lq2, lk1, lk2 = (apply_rope(t, cos, sin) for t in (lq1, lq2, lk1, lk2))
    lqg = apply_rope(rms_norm(lqg, qk_g[0]), cos, sin)
    lkg = apply_rope(rms_norm(lkg, qk_g[1]), cos, sin)
    cqg = rms_norm(cqg, qk_g[0])
    ckg = rms_norm(ckg, qk_g[1])

    def cat(a, b):
        return jnp.concatenate([a, b], axis=1)

    oa_l = diff_head_norm(diff_attention(lq1, lq2, cat(ck1, lk1), cat(ck2, lk2), cat(cva, lva), lam),
                          subln_g, lam_init)
    ob_l = fourier_mix(lu)
    oc_l = gqa_attention(lqg, cat(ckg, lkg), cat(cvg, lvg))
    out_l = gated_merge(hl, oa_l, ob_l, oc_l, w_branch, w_gate, b_gate, w_o)
    if not need_ctx_out:
        return out_l, None
    oa_c = diff_head_norm(diff_attention(cq1, cq2, ck1, ck2, cva, lam), subln_g, lam_init)
    ob_c = fourier_mix(cu)
    oc_c = gqa_attention(cqg, ckg, cvg)
    out_c = gated_merge(hc, oa_c, ob_c, oc_c, w_branch, w_gate, b_gate, w_o)
    return out_l, out_c


def dwconv3(a, w, b):
    ap = jnp.pad(a, ((0, 0), (1, 1), (0, 0)))
    return ap[:, :-2] * w[0] + ap[:, 1:-1] * w[1] + ap[:, 2:] * w[2] + b


def conv_ffn(h, w_up, conv_w, conv_b, w_down):
    a, g = jnp.split(h @ w_up, 2, axis=-1)
    return (jax.nn.gelu(dwconv3(a, conv_w, conv_b), approximate=False) * g) @ w_down


def setup_inputs(seed: int = 0) -> dict:
    key = jax.random.key(seed)
    ks = jax.random.split(key, 22)
    f32 = jnp.float32

    def nrm(k, shape, s):
        return jax.random.normal(k, shape, f32) * s

    d = D_MODEL
    return {
        'x': nrm(ks[0], (BATCH, SEQ, d), 1.0),
        'c': nrm(ks[1], (BATCH, d), 1.0),
        'ctx': nrm(ks[2], (BATCH, CTX_LEN, d), 1.0),
        'c_ctx': nrm(ks[3], (d,), 1.0),
        'w_ada': nrm(ks[4], (DEPTH, d, 6 * d), d ** -0.5),
        'b_ada': nrm(ks[5], (DEPTH, 6 * d), 0.02),
        'w_in': nrm(ks[6], (DEPTH, d, D_IN), d ** -0.5),
        'diff_lambda': nrm(ks[7], (DEPTH, 4, D_HEAD), 0.1),
        'diff_subln_g': 1.0 + nrm(ks[8], (DEPTH, DIFF_V), 0.02),
        'qk_norm_g': 1.0 + nrm(ks[9], (DEPTH, 2, D_HEAD), 0.02),
        'w_branch': nrm(ks[10], (DEPTH, N_BRANCH, BRANCH_W, d), BRANCH_W ** -0.5),
        'w_gate': nrm(ks[11], (DEPTH, d, N_BRANCH * d), d ** -0.5),
        'b_gate': nrm(ks[12], (DEPTH, N_BRANCH * d), 0.02),
        'w_o': nrm(ks[13], (DEPTH, d, d), d ** -0.5 * DEEPNORM_BETA),
        'ln1_g': 1.0 + nrm(ks[14], (DEPTH, d), 0.02),
        'ln1_b': nrm(ks[15], (DEPTH, d), 0.02),
        'w_up': nrm(ks[16], (DEPTH, d, 2 * D_FF), d ** -0.5),
        'conv_w': nrm(ks[17], (DEPTH, CONV_W, D_FF), CONV_W ** -0.5),
        'conv_b': nrm(ks[18], (DEPTH, D_FF), 0.02),
        'w_down': nrm(ks[19], (DEPTH, D_FF, d), D_FF ** -0.5 * DEEPNORM_BETA),
        'ln2_g': 1.0 + nrm(ks[20], (DEPTH, d), 0.02),
        'ln2_b': nrm(ks[21], (DEPTH, d), 0.02),
    }


def reference(x, c, ctx, c_ctx, w_ada, b_ada, w_in, diff_lambda, diff_subln_g, qk_norm_g,
              w_branch, w_gate, b_gate, w_o, ln1_g, ln1_b, w_up, conv_w, conv_b, w_down,
              ln2_g, ln2_b):
    cos, sin = axial_rope_tables(x.shape[1], x.dtype)
    xl, xc = x, ctx
    for l in range(DEPTH):
        last = l == DEPTH - 1
        lam_init = 0.8 - 0.6 * math.exp(-0.3 * l)
        ml = jnp.split((jax.nn.silu(c) @ w_ada[l] + b_ada[l])[:, None, :], 6, axis=-1)
        mc = jnp.split(jax.nn.silu(c_ctx) @ w_ada[l] + b_ada[l], 6, axis=-1)
        lp = diff_lambda[l].astype(jnp.float32)
        lam = jnp.exp(jnp.sum(lp[0] * lp[1])) - jnp.exp(jnp.sum(lp[2] * lp[3])) + lam_init

        hl = xl * (1 + ml[1]) + ml[0]
        hc = xc * (1 + mc[1]) + mc[0]
        ol, oc = token_mixer(hl, hc, not last, cos, sin, w_in[l], lam, lam_init, diff_subln_g[l],
                             qk_norm_g[l], w_branch[l], w_gate[l], b_gate[l], w_o[l])
        xl = layer_norm(DEEPNORM_ALPHA * xl + ml[2] * ol, ln1_g[l], ln1_b[l])

        hl = xl * (1 + ml[4]) + ml[3]
        xl = layer_norm(DEEPNORM_ALPHA * xl + ml[5] * conv_ffn(hl, w_up[l], conv_w[l], conv_b[l], w_down[l]),
                        ln2_g[l], ln2_b[l])

        if not last:
            xc = layer_norm(DEEPNORM_ALPHA * xc + mc[2] * oc, ln1_g[l], ln1_b[l])
            hc = xc * (1 + mc[4]) + mc[3]
            xc = layer_norm(DEEPNORM_ALPHA * xc + mc[5] * conv_ffn(hc, w_up[l], conv_w[l], conv_b[l], w_down[l]),
                            ln2_g[l], ln2_b[l])
    return xl
```

```cpp
#include <hip/hip_runtime.h>
#include <cstdio>
#include <cstdint>

#ifndef MK_N_LAUNCHES
#define MK_N_LAUNCHES 1
#endif

#define LAS __attribute__((address_space(3)))
#define GAS __attribute__((address_space(1)))
typedef unsigned short bf16_t;
typedef short bf16x8 __attribute__((ext_vector_type(8)));
typedef short s16x4 __attribute__((ext_vector_type(4)));
typedef float f32x2 __attribute__((ext_vector_type(2)));
typedef float f32x4 __attribute__((ext_vector_type(4)));
typedef float f32x16 __attribute__((ext_vector_type(16)));
typedef unsigned u32x2 __attribute__((ext_vector_type(2)));
typedef unsigned u32x4 __attribute__((ext_vector_type(4)));

constexpr int DM = 4096, NB = 2, SEQ = 4096, CTX = 256, LT = SEQ + CTX, M = NB * LT;
constexpr int DIN = 11264, NGATE = 12288, N1 = DIN + NGATE, DFF = 11008, NUP = 2 * DFF, BW = 2048;
constexpr int C_AQ = 0, C_AK = 2048, C_AV = 4096, C_BU = 6144, C_CQ = 8192, C_CK = 10240, C_CV = 10752, C_G = 11264;
constexpr int NLAYER = 2, NADA = 6 * DM;
constexpr float NORM_EPS = 1e-6f;
constexpr float DN_ALPHA = 1.4142135623730951f;
constexpr int NWAVES = 8, NTHREADS = 512;
constexpr int PH_PRO = 2, PH_PER_LAYER = 10, NPH = PH_PRO + NLAYER * PH_PER_LAYER;

constexpr size_t MiB = 1ull << 20;
constexpr size_t WS_CTL = 0, CTL_ZERO_BYTES = 1 * MiB;
constexpr size_t WS_MODP = 1 * MiB;
constexpr size_t WS_MOD = 3 * MiB;
constexpr size_t WS_ROPE = 4 * MiB;
constexpr size_t WS_DC = 6 * MiB;
constexpr size_t WS_FCTX = 6 * MiB + 512 * 1024;
constexpr size_t WS_F = 8 * MiB;
constexpr size_t WS_W = 72 * MiB;
constexpr size_t W_1 = 0, W_B = 184 * MiB, W_O = 232 * MiB, W_UP = 264 * MiB, W_DN = 436 * MiB, W_LAYER = 522 * MiB;
constexpr size_t WS_X = 1116 * MiB;
constexpr size_t WS_Y = 1252 * MiB;
constexpr size_t WS_H = 1388 * MiB;
constexpr size_t WS_MB = 1456 * MiB;
constexpr size_t WS_PG = 1524 * MiB;
constexpr size_t WS_AG = WS_PG;
constexpr size_t WS_OA1 = 1915 * MiB, WS_OA2 = 1983 * MiB;
constexpr size_t WS_BR = 2051 * MiB;
constexpr size_t WS_U2 = WS_OA1;
constexpr size_t WS_YT = 2153 * MiB;
constexpr size_t WS_YTC = 2217 * MiB;
constexpr size_t WS_AE = 2221 * MiB, WS_CP = 2224 * MiB, WS_GP = 2227 * MiB;
constexpr size_t WS_YP = 2230 * MiB;
constexpr size_t WS_KV = 2294 * MiB;
constexpr size_t WS_END = 2380 * MiB;

constexpr int RING_BYTES = 131072, LDSCTL_OFF = RING_BYTES, LDS_EX_OFF = RING_BYTES + 1024, LDS_BYTES = 147456;

#define RLX_AGENT __ATOMIC_RELAXED, __HIP_MEMORY_SCOPE_AGENT
#define LDS_WAIT() asm volatile("s_waitcnt lgkmcnt(0)" ::: "memory")
#define VM_WAIT() asm volatile("s_waitcnt vmcnt(0)" ::: "memory")
__device__ __forceinline__ unsigned f2bf(float f) { unsigned u = __builtin_bit_cast(unsigned, f); return (u + 0x7fffu + ((u >> 16) & 1u)) >> 16; }
__device__ __forceinline__ unsigned pk2(float lo, float hi) { return f2bf(lo) | (f2bf(hi) << 16); }
__device__ __forceinline__ float bflo(unsigned w) { return __builtin_bit_cast(float, w << 16); }
__device__ __forceinline__ float bfhi(unsigned w) { return __builtin_bit_cast(float, w & 0xffff0000u); }
__device__ __forceinline__ unsigned cvt_pk_bf16(float lo, float hi) { unsigned r; asm volatile("v_cvt_pk_bf16_f32 %0, %1, %2" : "=v"(r) : "v"(lo), "v"(hi)); return r; }
__device__ __forceinline__ float wave_sum(float v) {
#pragma unroll
    for (int o = 1; o < 64; o <<= 1) v += __shfl_xor(v, o);
    return v;
}
__device__ __forceinline__ float half_sum(float v) {
#pragma unroll
    for (int o = 1; o < 32; o <<= 1) v += __shfl_xor(v, o);
    return v;
}
__device__ __forceinline__ f32x2 gelu_pk(f32x2 v) {
    const f32x2 av = __builtin_elementwise_abs(v), d = av * 0.2316418882f + 1.0f;
    f32x2 t; t.x = __builtin_amdgcn_rcpf(d.x); t.y = __builtin_amdgcn_rcpf(d.y);
    f32x2 q = t * 0.5307027145f + (-0.7265760135f); q = q * t + 0.7107068705f; q = q * t + (-0.142248368f); q = q * t + 0.127414796f; q = q * t;
    const f32x2 s = (v * v) * (-0.72134752044f);
    f32x2 e; e.x = __builtin_amdgcn_exp2f(s.x); e.y = __builtin_amdgcn_exp2f(s.y);
    const f32x2 m = v * (q * e), r = v - m;
    f32x2 o; o.x = v.x < 0.f ? m.x : r.x; o.y = v.y < 0.f ? m.y : r.y; return o;
}
__device__ __forceinline__ float sigmoidf_(float z) { return __builtin_amdgcn_rcpf(1.0f + __builtin_amdgcn_exp2f(-1.4426950408889634f * z)); }

#define XB_TMO      128
#define XB_XCNT(j)  (256  + 64 * (j))
#define XB_XSUB(j)  (1280 + 64 * (j))
#define XB_XGEN(j)  (2304 + 64 * (j))
#define XB_TOP      3328
#define XB_TOPGEN   3392
#define XCD_BAR_WORDS 3456
#define XB_SPIN_CAP (1u << 18)
__device__ __forceinline__ unsigned xb_ld(unsigned* p)              { return __hip_atomic_load(p, __ATOMIC_RELAXED, __HIP_MEMORY_SCOPE_AGENT); }
__device__ __forceinline__ unsigned xb_add(unsigned* p, unsigned v) { return __hip_atomic_fetch_add(p, v, __ATOMIC_RELAXED, __HIP_MEMORY_SCOPE_AGENT); }
__device__ __forceinline__ unsigned xb_xcc_id() { return (unsigned)__builtin_amdgcn_s_getreg((3 << 11) | 20) & 0xFu; }
#define XB_SPIN(cond, bar) do { unsigned _sp = 0; while (cond) { __builtin_amdgcn_s_sleep(1); \
    if ((++_sp & 255u) == 0u) { if (xb_ld(&(bar)[XB_TMO])) break; if (_sp > XB_SPIN_CAP) { atomicAdd(&(bar)[XB_TMO], 1u); break; } } } } while (0)
struct XcdBarrier { unsigned* bar; unsigned x; volatile LAS unsigned* st; };
__device__ __forceinline__ XcdBarrier xcd_barrier_post(unsigned* bar, volatile LAS unsigned* st) {
    XcdBarrier b; b.bar = bar; b.x = xb_xcc_id(); b.st = st;
    if (threadIdx.x == 0) (void)xb_add(&bar[XB_XCNT(b.x)], 1u);
    return b;
}
__device__ __forceinline__ void xcd_barrier_complete(unsigned* bar, unsigned x, unsigned& nloc, unsigned& nx) {
    const unsigned G = gridDim.x * gridDim.y * gridDim.z;
    unsigned sum, cnt, mine, sp = 0u;
    for (;;) {
        sum = 0u; cnt = 0u; mine = 0u;
#pragma unroll
        for (unsigned j = 0; j < 16; ++j) { const unsigned c = xb_ld(&bar[XB_XCNT(j)]); sum += c; cnt += (c > 0u) ? 1u : 0u; mine = (j == x) ? c : mine; }
        if (sum == G) break;
        __builtin_amdgcn_s_sleep(1);
        if ((++sp & 255u) == 0u) { if (xb_ld(&bar[XB_TMO])) break; if (sp > XB_SPIN_CAP) { atomicAdd(&bar[XB_TMO], 1u); break; } }
    }
    nloc = mine > 0u ? mine : 1u; nx = cnt > 0u ? cnt : 1u;
}
__device__ __forceinline__ void xcd_barrier(const XcdBarrier& b) {
    asm volatile("s_waitcnt vmcnt(0)" ::: "memory");
    __syncthreads();
    if (threadIdx.x == 0) {
        unsigned* bar = b.bar;
        __builtin_amdgcn_s_waitcnt(0);
        unsigned nloc = b.st[0], nx = b.st[1];
        if (nloc == 0u) { xcd_barrier_complete(bar, b.x, nloc, nx); b.st[0] = nloc; b.st[1] = nx; }
        const unsigned old = xb_add(&bar[XB_XSUB(b.x)], 1u);
        const unsigned gen = old / nloc;
        if (old + 1u == (gen + 1u) * nloc) {
            __builtin_amdgcn_fence(__ATOMIC_RELEASE, "agent");
            asm volatile("s_waitcnt vmcnt(0)" ::: "memory");
            const unsigned og = xb_add(&bar[XB_TOP], 1u);
            const unsigned tg = og / nx;
            if (og + 1u == (tg + 1u) * nx) xb_add(&bar[XB_TOPGEN], 1u);
            else XB_SPIN(xb_ld(&bar[XB_TOPGEN]) == tg, bar);
            __builtin_amdgcn_fence(__ATOMIC_ACQUIRE, "agent");
            xb_add(&bar[XB_XGEN(b.x)], 1u);
            asm volatile("s_waitcnt vmcnt(0)" ::: "memory");
        } else {
            XB_SPIN(xb_ld(&bar[XB_XGEN(b.x)]) == gen, bar);
            __builtin_amdgcn_fence(__ATOMIC_ACQUIRE, "agent");
            asm volatile("s_waitcnt vmcnt(0)" ::: "memory");
        }
    }
    __syncthreads();
}

namespace pg8 {
constexpr int BM = 256, BK = 64, HALF = 128, HTB = HALF * BK * 2, STAGE_BYTES = 8 * HTB, NXCD = 8, WGM = 8;
__host__ __device__ __forceinline__ int lds_byte(int r, int c) { const int st = (r >> 4) * 2 + (c >> 5), rr = r & 15, cc = c & 31, ob = rr * 64 + cc * 2; return st * 1024 + (ob ^ (((ob >> 9) & 1) << 5)); }
__host__ __device__ __forceinline__ void stage_rc(int b, int& R, int& C) { const int st = b / 1024, sb = b % 1024, swz = sb ^ (((sb >> 9) & 1) << 5); R = (st >> 1) * 16 + swz / 64; C = (st & 1) * 32 + (swz % 64) / 2; }
__host__ __device__ __forceinline__ int perm32(int rho) { const int n = rho >> 4, i = rho & 15; return 8 * (i >> 2) + 4 * n + (i & 3); }

struct Unit { int pm, pn, z, kb, nt; };
struct Gemm { const bf16_t* A; const bf16_t* Bt; int lda, ldb, K; size_t zA, zB; };

template <int SEG> struct TileOrder {
    int nM, nN, nz, nwg, G, c, lat, nextra;
    __device__ __forceinline__ void init(int nM_, int nN_, int nz_, int G_, int c_, int lat_ = 0, int nextra_ = 0) { lat = lat_; nextra = nextra_; nM = lat ? 32 : nM_; nN = nN_; nz = nz_; nwg = nM * nN * nz; G = G_; c = c_; }
    __device__ __forceinline__ bool next(int i, Unit& u) const {
        const int ti = i / SEG, sg = i - ti * SEG;
        const long L = (long)ti * G + c; if (L >= nwg + nextra) return false;
        u.kb = 0; u.nt = 0;
        if (L >= nwg) { const int idx = (int)L - nwg, t = idx / 20, j = idx - t * 20; u.pm = t * 17; u.pn = j < 16 ? 8 + j : 24 + j; u.z = 0; return true; }
        int wgid = (int)L; { const int q = nwg / NXCD, r = nwg % NXCD, xcd = wgid % NXCD, off = wgid / NXCD; wgid = (xcd < r ? xcd * (q + 1) : r * (q + 1) + (xcd - r) * q) + off; }
        const int per = nM * nN, zz = wgid / per; wgid -= zz * per;
        const int nig = WGM * nN, gid = wgid / nig, fm = gid * WGM, gsz = (nM - fm) < WGM ? (nM - fm) : WGM;
        int pm = fm + ((wgid % nig) % gsz); if (lat) pm += 1 + (pm >= 16);
        u.pm = pm; u.pn = (wgid % nig) / gsz; u.z = (SEG > 1) ? sg : zz; return true;
    }
};

struct SplitOrder { int G, c, nta, ntb, nsub;
    __device__ __forceinline__ void init(int G_, int c_, int nta_, int ntb_, int nsub_) { G = G_; c = c_; nta = nta_; ntb = ntb_; nsub = nsub_; }
    __device__ __forceinline__ bool next(int i, Unit& u) const {
        const int L = i * G + c;
        const bool ok = L < 512 + nsub;
        const int w = (L & 7) * 64 + (L >> 3);
        const int gid = w >> 7, r = w & 127; int pm_l = gid * 8 + (r & 7); pm_l += 1 + (pm_l >= 16); const int pn_l = r >> 3;
        const int idx = L - 512, tile = idx >> 3, sp = idx & 7;
        const bool lat = L < 512;
        const int pm = lat ? pm_l : (tile >> 4) * 17, pn = lat ? pn_l : (tile & 15), z = lat ? 0 : sp;
        const int nt = lat ? 0 : (sp < 6 ? nta : ntb), kb = lat ? 0 : (sp < 6 ? sp * nta : 6 * nta + (sp - 6) * ntb) * BK;
        u.pm = pm; u.pn = pn; u.z = z; u.kb = kb; u.nt = nt;
        return ok;
    }
};

template <class Epi, class Sched, bool VARK = false, bool ALIGN_EPI = true, bool SP2 = true>
__device__ __forceinline__ void gemm_phase(LAS unsigned char* lds, const Gemm g, const Sched& S, const Epi& E) {
    int tid_ = threadIdx.x; asm volatile("" : "+v"(tid_));
    const int tid = tid_, wid = __builtin_amdgcn_readfirstlane(tid >> 6), lane = tid & 63, wr = wid >> 2, wc = wid & 3, fr = lane & 15, fq = lane >> 4;
    const int ntf = g.K / BK;
    unsigned voffA[2], voffB[2];
#pragma unroll
    for (int i = 0; i < 2; ++i) { int R, C; stage_rc(tid * 16 + i * 8192, R, C); const int Rb = Epi::PERM ? ((R & ~31) + perm32(R & 31)) : R;
        voffA[i] = (unsigned)(R * g.lda + C) * 2u; voffB[i] = (unsigned)(Rb * g.ldb + C) * 2u; }
    const size_t kstep = (size_t)(BK * 2);
    const size_t hstepA = (size_t)HALF * g.lda * 2, hstepB = (size_t)HALF * g.ldb * 2;
    const size_t tstepA = 2 * hstepA, tstepB = 2 * hstepB;
    const unsigned ldsw = (unsigned)wid * 1024u;
    const int aoff = lds_byte(wr * 64 + fr, fq * 8), boff = lds_byte(wc * 32 + fr, fq * 8);
#define PG8_SA(b, h) (((b) * 2 + (h)) * HTB)
#define PG8_SB(b, h) ((4 + (b) * 2 + (h)) * HTB)
#define PG8_STAGE(bufoff, gbase, voff) do { _Pragma("unroll") for (int _i = 0; _i < 2; ++_i) \
        __builtin_amdgcn_global_load_lds((const unsigned*)((const char*)(gbase) + (voff)[_i]), (LAS unsigned*)(lds + (bufoff) + ldsw + _i * 8192), 16, 0, 0); } while (0)
#define PG8_LDA(dst, b, h) do { _Pragma("unroll") for (int m = 0; m < 4; ++m) _Pragma("unroll") for (int k = 0; k < 2; ++k) dst[m][k] = *(const LAS bf16x8*)(lds + PG8_SA(b, h) + aoff + m * 2048 + k * 1024); } while (0)
#define PG8_LDB(dst, b, h) do { _Pragma("unroll") for (int n = 0; n < 2; ++n) _Pragma("unroll") for (int k = 0; k < 2; ++k) dst[n][k] = *(const LAS bf16x8*)(lds + PG8_SB(b, h) + boff + n * 2048 + k * 1024); } while (0)
#define PG8_MMA(ai, bj, At, Bt) do { __builtin_amdgcn_s_setprio(1); _Pragma("unroll") for (int m = 0; m < 4; ++m) _Pragma("unroll") for (int n = 0; n < 2; ++n) _Pragma("unroll") for (int k = 0; k < 2; ++k) \
        acc[ai][bj][m][n] = __builtin_amdgcn_mfma_f32_16x16x32_bf16(Bt[n][k], At[m][k], acc[ai][bj][m][n], 0, 0, 0); __builtin_amdgcn_s_setprio(0); } while (0)
#define PG8_WAIT_V(n) asm volatile("s_waitcnt vmcnt(" #n ")" ::: "memory")
#define PG8_WAIT_L(n) asm volatile("s_waitcnt lgkmcnt(" #n ")" ::: "memory")
#define PG8_BAR __builtin_amdgcn_s_barrier()
#define PG8_SCHED __builtin_amdgcn_sched_barrier(0)
    Unit cur{0, 0, 0, 0, 0}, nxt{0, 0, 0, 0, 0}; int ui = 0;
    if (!S.next(0, cur)) return;
    f32x4 acc[2][2][4][2];
#pragma unroll
    for (int a = 0; a < 2; ++a)
#pragma unroll
        for (int b = 0; b < 2; ++b)
#pragma unroll
            for (int m = 0; m < 4; ++m)
#pragma unroll
                for (int n = 0; n < 2; ++n) acc[a][b][m][n] = (f32x4){0.f, 0.f, 0.f, 0.f};
    bf16x8 At[4][2], B0[2][2], B1[2][2];
    const char* cA = (const char*)g.A + ((size_t)cur.z * g.zA + (VARK ? cur.kb : 0)) * 2 + (size_t)cur.pm * tstepA; const char* cB = (const char*)g.Bt + ((size_t)cur.z * g.zB + (VARK ? cur.kb : 0)) * 2 + (size_t)cur.pn * tstepB;
    if constexpr (SP2) {
        PG8_STAGE(PG8_SB(0, 0), cB, voffB); PG8_STAGE(PG8_SB(0, 1), cB + hstepB, voffB); PG8_STAGE(PG8_SA(0, 0), cA, voffA); PG8_STAGE(PG8_SA(0, 1), cA + hstepA, voffA);
        if (wr == 1) PG8_BAR;
        PG8_WAIT_V(2); PG8_BAR;
        PG8_STAGE(PG8_SB(1, 0), cB + kstep, voffB); PG8_STAGE(PG8_SA(1, 0), cA + kstep, voffA); PG8_STAGE(PG8_SB(1, 1), cB + hstepB + kstep, voffB);
        PG8_WAIT_V(6); PG8_BAR;
    } else {
        PG8_STAGE(PG8_SB(0, 0), cB, voffB); PG8_STAGE(PG8_SA(0, 0), cA, voffA); PG8_STAGE(PG8_SB(0, 1), cB + hstepB, voffB); PG8_STAGE(PG8_SA(0, 1), cA + hstepA, voffA);
        if (wr == 1) PG8_BAR;
        PG8_WAIT_V(4); PG8_BAR;
        PG8_STAGE(PG8_SB(1, 0), cB + kstep, voffB); PG8_STAGE(PG8_SA(1, 0), cA + kstep, voffA); PG8_STAGE(PG8_SB(1, 1), cB + hstepB + kstep, voffB);
        PG8_WAIT_V(6); PG8_BAR;
    }
#pragma unroll 1
    for (;;) {
        const bool has_next = S.next(ui + 1, nxt);
        const char* nA = has_next ? (const char*)g.A + ((size_t)nxt.z * g.zA + (VARK ? nxt.kb : 0)) * 2 + (size_t)nxt.pm * tstepA : cA;
        const char* nB = has_next ? (const char*)g.Bt + ((size_t)nxt.z * g.zB + (VARK ? nxt.kb : 0)) * 2 + (size_t)nxt.pn * tstepB : cB;
        const int nt = (VARK && cur.nt) ? cur.nt : ntf;
#pragma unroll 1
        for (int t = 0; t < nt; t += 2) {
            const bool last = (t == nt - 2);
            const char* a1 = cA + (size_t)(t + 1) * kstep;
            const char* a2 = last ? nA : cA + (size_t)(t + 2) * kstep; const char* b2 = last ? nB : cB + (size_t)(t + 2) * kstep;
            const char* a3 = a2 + kstep; const char* b3 = b2 + kstep;
            if constexpr (SP2) {
            PG8_LDB(B0, 0, 0); PG8_LDB(B1, 0, 1); PG8_SCHED; PG8_LDA(At, 0, 0); PG8_STAGE(PG8_SA(1, 1), a1 + hstepA, voffA);
            PG8_WAIT_V(8); PG8_WAIT_L(0); PG8_BAR; PG8_MMA(0, 0, At, B0); PG8_MMA(0, 1, At, B1); PG8_BAR; PG8_SCHED;
            PG8_LDA(At, 0, 1); PG8_STAGE(PG8_SB(0, 0), b2, voffB); PG8_STAGE(PG8_SB(0, 1), b2 + hstepB, voffB); PG8_STAGE(PG8_SA(0, 0), a2, voffA);
            PG8_WAIT_V(8); PG8_WAIT_L(0); PG8_BAR; PG8_MMA(1, 0, At, B0); PG8_MMA(1, 1, At, B1); PG8_BAR; PG8_SCHED;
            PG8_LDB(B0, 1, 0); PG8_LDB(B1, 1, 1); PG8_SCHED; PG8_LDA(At, 1, 0); PG8_STAGE(PG8_SA(0, 1), a2 + hstepA, voffA);
            PG8_WAIT_V(8); PG8_WAIT_L(0); PG8_BAR; PG8_MMA(0, 0, At, B0); PG8_MMA(0, 1, At, B1); PG8_BAR; PG8_SCHED;
            PG8_LDA(At, 1, 1); PG8_STAGE(PG8_SB(1, 0), b3, voffB); PG8_STAGE(PG8_SB(1, 1), b3 + hstepB, voffB); PG8_STAGE(PG8_SA(1, 0), a3, voffA);
            PG8_WAIT_V(8); PG8_WAIT_L(0); PG8_BAR; PG8_MMA(1, 0, At, B0); PG8_MMA(1, 1, At, B1); PG8_BAR; PG8_SCHED;
            } else {
            PG8_LDB(B0, 0, 0); PG8_SCHED; PG8_LDA(At, 0, 0); PG8_STAGE(PG8_SA(1, 1), a1 + hstepA, voffA);
            PG8_WAIT_L(8); PG8_BAR; PG8_WAIT_L(0); PG8_MMA(0, 0, At, B0); PG8_BAR; PG8_SCHED;
            PG8_LDB(B1, 0, 1); PG8_STAGE(PG8_SB(0, 0), b2, voffB);
            PG8_BAR; PG8_WAIT_L(0); PG8_MMA(0, 1, At, B1); PG8_BAR;
            PG8_LDA(At, 0, 1); PG8_STAGE(PG8_SA(0, 0), a2, voffA);
            PG8_BAR; PG8_WAIT_L(0); PG8_MMA(1, 0, At, B0); PG8_BAR; PG8_SCHED;
            PG8_STAGE(PG8_SB(0, 1), b2 + hstepB, voffB);
            PG8_WAIT_V(6); PG8_BAR; PG8_MMA(1, 1, At, B1); PG8_BAR;
            PG8_LDB(B0, 1, 0); PG8_SCHED; PG8_LDA(At, 1, 0); PG8_STAGE(PG8_SA(0, 1), a2 + hstepA, voffA);
            PG8_WAIT_L(8); PG8_BAR; PG8_WAIT_L(0); PG8_MMA(0, 0, At, B0); PG8_BAR; PG8_SCHED;
            PG8_LDB(B1, 1, 1); PG8_STAGE(PG8_SB(1, 0), b3, voffB);
            PG8_BAR; PG8_WAIT_L(0); PG8_MMA(0, 1, At, B1); PG8_BAR;
            PG8_LDA(At, 1, 1); PG8_STAGE(PG8_SA(1, 0), a3, voffA);
            PG8_BAR; PG8_WAIT_L(0); PG8_MMA(1, 0, At, B0); PG8_BAR; PG8_SCHED;
            PG8_STAGE(PG8_SB(1, 1), b3 + hstepB, voffB);
            PG8_WAIT_V(6); PG8_BAR; PG8_MMA(1, 1, At, B1); PG8_BAR;
            }
        }
        if constexpr (ALIGN_EPI) { if (wr == 0) PG8_BAR; }
        E(acc, cur, wr, wc, fr, fq);
        if (!has_next) break;
        if (!E.keep(cur)) {
#pragma unroll
        for (int a = 0; a < 2; ++a)
#pragma unroll
            for (int b = 0; b < 2; ++b)
#pragma unroll
                for (int m = 0; m < 4; ++m)
#pragma unroll
                    for (int n = 0; n < 2; ++n) acc[a][b][m][n] = (f32x4){0.f, 0.f, 0.f, 0.f};
        }
        cur.pm = nxt.pm; cur.pn = nxt.pn; cur.z = nxt.z; cur.kb = nxt.kb; cur.nt = nxt.nt; cA = nA; cB = nB; ++ui;
        if constexpr (ALIGN_EPI) { if (wr == 1) PG8_BAR; }
    }
    PG8_WAIT_V(0);
    if constexpr (!ALIGN_EPI) { if (wr == 0) PG8_BAR; }
    PG8_BAR;
#undef PG8_SA
#undef PG8_SB
#undef PG8_STAGE
#undef PG8_LDA
#undef PG8_LDB
#undef PG8_MMA
#undef PG8_WAIT_V
#undef PG8_WAIT_L
#undef PG8_BAR
#undef PG8_SCHED
}

typedef f32x4 Acc[2][2][4][2];

struct EpiBf16 {
    static constexpr bool PERM = true;
    bf16_t* O; int ldc; size_t zO; int row_off; const float* bias; int sig_pn0;
    __device__ __forceinline__ bool keep(const Unit&) const { return false; }
    __device__ __forceinline__ void operator()(Acc& acc, const Unit& u, int wr, int wc, int fr, int fq) const {
        const int row0 = row_off + u.pm * BM + wr * 64 + fr, col0 = u.pn * BM + wc * 32 + 8 * fq;
        bf16_t* base = O + (size_t)u.z * zO;
        const bool sig = u.pn >= sig_pn0;
        f32x4 bv[2][2];
#pragma unroll
        for (int bj = 0; bj < 2; ++bj)
#pragma unroll
            for (int n = 0; n < 2; ++n) bv[bj][n] = sig ? *(const f32x4*)(bias + (col0 - sig_pn0 * BM) + bj * HALF + 4 * n) : (f32x4){0.f, 0.f, 0.f, 0.f};
#pragma unroll
        for (int ai = 0; ai < 2; ++ai)
#pragma unroll
            for (int m = 0; m < 4; ++m) { bf16_t* rowp = base + (size_t)(row0 + ai * HALF + m * 16) * ldc + col0;
#pragma unroll
                for (int bj = 0; bj < 2; ++bj) { f32x4 v0 = acc[ai][bj][m][0], v1 = acc[ai][bj][m][1];
                    if (sig) { v0 += bv[bj][0]; v1 += bv[bj][1];
#pragma unroll
                        for (int j = 0; j < 4; ++j) { v0[j] = sigmoidf_(v0[j]); v1[j] = sigmoidf_(v1[j]); } }
                    u32x4 w; w.x = cvt_pk_bf16(v0[0], v0[1]); w.y = cvt_pk_bf16(v0[2], v0[3]); w.z = cvt_pk_bf16(v1[0], v1[1]); w.w = cvt_pk_bf16(v1[2], v1[3]);
                    *(u32x4*)(rowp + bj * HALF) = w; } }
    }
};
struct EpiF1 {
    static constexpr bool PERM = true;
    bf16_t* YT; bf16_t* YTC;
    __device__ __forceinline__ bool keep(const Unit&) const { return false; }
    __device__ __forceinline__ void operator()(Acc& acc, const Unit& u, int wr, int wc, int fr, int fq) const {
        const int b = u.pn / 17, pt = u.pn - b * 17;
        const int cp0 = wr * 64 + fr, tk0 = wc * 32 + 8 * fq;
        bf16_t* base; int ld;
        if (pt == 0) { base = YTC + ((size_t)(b * 8 + u.z) * 256) * 512 + u.pm * 256; ld = 512; }
        else { base = YT + ((size_t)(b * 8 + u.z) * 256) * 8192 + u.pm * 4096 + (pt - 1) * 256; ld = 8192; }
#pragma unroll
        for (int ai = 0; ai < 2; ++ai)
#pragma unroll
            for (int m = 0; m < 4; ++m) { bf16_t* rowp = base + (size_t)(cp0 + ai * HALF + m * 16) * ld + tk0;
#pragma unroll
                for (int bj = 0; bj < 2; ++bj) { const f32x4 v0 = acc[ai][bj][m][0], v1 = acc[ai][bj][m][1];
                    u32x4 w; w.x = cvt_pk_bf16(v0[0], v0[1]); w.y = cvt_pk_bf16(v0[2], v0[3]); w.z = cvt_pk_bf16(v1[0], v1[1]); w.w = cvt_pk_bf16(v1[2], v1[3]);
                    *(u32x4*)(rowp + bj * HALF) = w; } }
    }
};
struct EpiBranch {
    static constexpr bool PERM = true;
    const bf16_t* G; bf16_t* O;
    __device__ __forceinline__ bool keep(const Unit& u) const { return u.z < 2; }
    __device__ __forceinline__ void operator()(Acc& acc, const Unit& u, int wr, int wc, int fr, int fq) const {
        const int row0 = u.pm * BM + wr * 64 + fr, col0 = u.pn * BM + wc * 32 + 8 * fq;
#pragma unroll
        for (int ai = 0; ai < 2; ++ai)
#pragma unroll
            for (int m = 0; m < 4; ++m) { const size_t row = (size_t)(row0 + ai * HALF + m * 16);
#pragma unroll
                for (int bj = 0; bj < 2; ++bj) {
                    const u32x4 ga = *(const u32x4*)(G + row * N1 + u.z * DM + col0 + bj * HALF);
                    float s[8] = {bflo(ga.x), bfhi(ga.x), bflo(ga.y), bfhi(ga.y), bflo(ga.z), bfhi(ga.z), bflo(ga.w), bfhi(ga.w)};
                    if (u.z < 2) { const u32x4 gb = *(const u32x4*)(G + row * N1 + (u.z + 1) * DM + col0 + bj * HALF);
                        const float d[8] = {bflo(gb.x), bfhi(gb.x), bflo(gb.y), bfhi(gb.y), bflo(gb.z), bfhi(gb.z), bflo(gb.w), bfhi(gb.w)};
#pragma unroll
                        for (int j = 0; j < 8; ++j) s[j] = fmaxf(s[j], 1e-20f) * __builtin_amdgcn_rcpf(fmaxf(d[j], 1e-20f)); }
                    else {
#pragma unroll
                        for (int j = 0; j < 8; ++j) s[j] = fmaxf(s[j], 1e-20f); }
                    f32x4 v0 = acc[ai][bj][m][0], v1 = acc[ai][bj][m][1];
#pragma unroll
                    for (int j = 0; j < 4; ++j) { v0[j] *= s[j]; v1[j] *= s[4 + j]; }
                    acc[ai][bj][m][0] = v0; acc[ai][bj][m][1] = v1;
                    if (u.z == 2) { u32x4 w; w.x = cvt_pk_bf16(v0[0], v0[1]); w.y = cvt_pk_bf16(v0[2], v0[3]); w.z = cvt_pk_bf16(v1[0], v1[1]); w.w = cvt_pk_bf16(v1[2], v1[3]);
                        *(u32x4*)(O + row * DM + col0 + bj * HALF) = w; } } }
    }
};
struct EpiResid {
    static constexpr bool PERM = false;
    const float* X; float* Y; const float* gate; float* YP;
    __device__ __forceinline__ bool keep(const Unit&) const { return false; }
    __device__ __forceinline__ void operator()(Acc& acc, const Unit& u, int wr, int wc, int fr, int fq) const {
        const int row0 = u.pm * BM + wr * 64 + fr, col0 = u.pn * BM + wc * 32 + 4 * fq;
        if (u.nt) {
            float* yp = YP + ((size_t)u.z * 512 + (u.pm / 17) * 256 + wr * 64 + fr) * DM + col0;
#pragma unroll
            for (int ai = 0; ai < 2; ++ai)
#pragma unroll
                for (int m = 0; m < 4; ++m)
#pragma unroll
                    for (int bj = 0; bj < 2; ++bj)
#pragma unroll
                        for (int n = 0; n < 2; ++n) *(f32x4*)(yp + (size_t)(ai * HALF + m * 16) * DM + bj * HALF + n * 16) = acc[ai][bj][m][n];
            return; }
        const int b = u.pm / 17, j = (u.pm - b * 17 == 0) ? 2 : b;
        const float* gv = gate + (size_t)j * NADA + col0;
        f32x4 gt[2][2];
#pragma unroll
        for (int bj = 0; bj < 2; ++bj)
#pragma unroll
            for (int n = 0; n < 2; ++n) gt[bj][n] = *(const f32x4*)(gv + bj * HALF + n * 16);
#pragma unroll
        for (int ai = 0; ai < 2; ++ai)
#pragma unroll
            for (int m = 0; m < 4; ++m) { const size_t off = (size_t)(row0 + ai * HALF + m * 16) * DM + col0;
#pragma unroll
                for (int bj = 0; bj < 2; ++bj)
#pragma unroll
                    for (int n = 0; n < 2; ++n) { const f32x4 xv = *(const f32x4*)(X + off + bj * HALF + n * 16);
                        *(f32x4*)(Y + off + bj * HALF + n * 16) = xv * DN_ALPHA + gt[bj][n] * acc[ai][bj][m][n]; }
                asm volatile("" ::: "memory"); }
    }
};
struct EpiProj {
    static constexpr bool PERM = true;
    bf16_t* O; const float* bias; const float* qkg; const float* rope; LAS float* EX; bf16_t* KV;
    __device__ __forceinline__ bool keep(const Unit&) const { return false; }
    __device__ __forceinline__ void operator()(Acc& acc, const Unit& u, int wr, int wc, int fr, int fq) const {
        const int row0 = u.pm * BM + wr * 64 + fr, col0 = u.pn * BM + wc * 32 + 8 * fq;
        const int pt = u.pm % 17; const bool lat = pt != 0;
        const int kind = (u.pn < 16) ? 1 : ((u.pn >= 32 && u.pn < 42) ? 2 : ((u.pn >= 44) ? 3 : 0));
        const int i0 = 16 * wc + 4 * fq;
        if (kind == 2) {
#pragma unroll
            for (int ai = 0; ai < 2; ++ai)
#pragma unroll
                for (int m = 0; m < 4; ++m)
#pragma unroll
                    for (int bj = 0; bj < 2; ++bj) { const f32x4 v0 = acc[ai][bj][m][0], v1 = acc[ai][bj][m][1];
                        float ss = (v0[0] * v0[0] + v0[1] * v0[1]) + (v0[2] * v0[2] + v0[3] * v0[3]) + (v1[0] * v1[0] + v1[1] * v1[1]) + (v1[2] * v1[2] + v1[3] * v1[3]);
                        ss += __shfl_xor(ss, 16); ss += __shfl_xor(ss, 32);
                        if (fq == 0) EX[((ai * HALF + wr * 64 + m * 16 + fr) * 2 + bj) * 4 + wc] = ss; }
            asm volatile("s_waitcnt lgkmcnt(0)" ::: "memory"); __builtin_amdgcn_s_barrier(); asm volatile("" ::: "memory");
            const float* gg = qkg + (u.pn >= 40 ? 128 : 0);
            const f32x4 gA = *(const f32x4*)(gg + i0), gB = *(const f32x4*)(gg + 64 + i0);
#pragma unroll
            for (int ai = 0; ai < 2; ++ai)
#pragma unroll
                for (int m = 0; m < 4; ++m)
#pragma unroll
                    for (int bj = 0; bj < 2; ++bj) { const f32x4 p = *(const LAS f32x4*)(EX + ((ai * HALF + wr * 64 + m * 16 + fr) * 2 + bj) * 4);
                        const float r = 1.0f / sqrtf(((p[0] + p[1]) + (p[2] + p[3])) * (1.0f / 128.0f) + NORM_EPS);
                        f32x4 v0 = acc[ai][bj][m][0], v1 = acc[ai][bj][m][1];
                        v0[0] *= r * gA[0]; v0[1] *= r * gB[0]; v0[2] *= r * gA[1]; v0[3] *= r * gB[1];
                        v1[0] *= r * gA[2]; v1[1] *= r * gB[2]; v1[2] *= r * gA[3]; v1[3] *= r * gB[3];
                        acc[ai][bj][m][0] = v0; acc[ai][bj][m][1] = v1; }
        }
        const bool sig = kind == 3;
        f32x4 bv[2][2];
#pragma unroll
        for (int bj = 0; bj < 2; ++bj)
#pragma unroll
            for (int n = 0; n < 2; ++n) bv[bj][n] = sig ? *(const f32x4*)(bias + (col0 - DIN) + bj * HALF + 4 * n) : (f32x4){0.f, 0.f, 0.f, 0.f};
        const bool dorope = lat && (kind == 1 || kind == 2);
        const int t0 = (pt - 1) * 256 + wr * 64 + fr;
        const bool iskv = (u.pn >= 8 && u.pn < 24) || (u.pn >= 40 && u.pn < 44);
        const int slot0 = (u.pn < 24) ? (u.pn - 8) * 2 : 32 + (u.pn - 40) * 2;
        bf16_t* kvb = KV + (((size_t)((u.pm / 17) * 40 + slot0)) * LT + pt * 256 + wr * 64 + fr) * 128 + wc * 32 + 8 * fq;
#pragma unroll
        for (int ai = 0; ai < 2; ++ai)
#pragma unroll
            for (int m = 0; m < 4; ++m) { bf16_t* rowp = O + (size_t)(row0 + ai * HALF + m * 16) * N1 + col0;
                f32x4 cs0 = {1.f, 0.f, 1.f, 0.f}, cs1 = cs0;
                if (dorope) { const float* rp = rope + ((size_t)(t0 + ai * HALF + m * 16) * 64 + i0) * 2; cs0 = *(const f32x4*)rp; cs1 = *(const f32x4*)(rp + 4); }
#pragma unroll
                for (int bj = 0; bj < 2; ++bj) { f32x4 v0 = acc[ai][bj][m][0], v1 = acc[ai][bj][m][1];
                    if (sig) { v0 += bv[bj][0]; v1 += bv[bj][1];
#pragma unroll
                        for (int j = 0; j < 4; ++j) { v0[j] = sigmoidf_(v0[j]); v1[j] = sigmoidf_(v1[j]); } }
                    if (dorope) {
                        const f32x4 a = v0, b = v1;
                        v0[0] = a[0] * cs0[0] - a[1] * cs0[1]; v0[1] = a[1] * cs0[0] + a[0] * cs0[1]; v0[2] = a[2] * cs0[2] - a[3] * cs0[3]; v0[3] = a[3] * cs0[2] + a[2] * cs0[3];
                        v1[0] = b[0] * cs1[0] - b[1] * cs1[1]; v1[1] = b[1] * cs1[0] + b[0] * cs1[1]; v1[2] = b[2] * cs1[2] - b[3] * cs1[3]; v1[3] = b[3] * cs1[2] + b[2] * cs1[3]; }
                    u32x4 w; w.x = cvt_pk_bf16(v0[0], v0[1]); w.y = cvt_pk_bf16(v0[2], v0[3]); w.z = cvt_pk_bf16(v1[0], v1[1]); w.w = cvt_pk_bf16(v1[2], v1[3]);
                    if (iskv) *(u32x4*)(kvb + (size_t)bj * LT * 128 + (size_t)(ai * HALF + m * 16) * 128) = w;
                    else *(u32x4*)(rowp + bj * HALF) = w; } }
    }
};
struct EpiConv {
    static constexpr bool PERM = true;
    bf16_t* U2; const float* cw; const float* cb; float* AE; float* CP; float* GP; LAS float* EX;
    __device__ __forceinline__ bool keep(const Unit&) const { return false; }
    __device__ __forceinline__ void operator()(Acc& acc, const Unit& u, int wr, int wc, int fr, int fq) const {
        const int lane = fr + 16 * fq;
#pragma unroll
        for (int ai = 0; ai < 2; ++ai) { const int q = 2 * ai + wr;
            if (fr == 0) { *(LAS f32x4*)(EX + ((q * 2 + 0) * 4 + wc) * 32 + 8 * fq) = acc[ai][0][0][0]; *(LAS f32x4*)(EX + ((q * 2 + 0) * 4 + wc) * 32 + 8 * fq + 4) = acc[ai][0][0][1]; }
            if (fr == 15) { *(LAS f32x4*)(EX + ((q * 2 + 1) * 4 + wc) * 32 + 8 * fq) = acc[ai][0][3][0]; *(LAS f32x4*)(EX + ((q * 2 + 1) * 4 + wc) * 32 + 8 * fq + 4) = acc[ai][0][3][1]; } }
        asm volatile("s_waitcnt lgkmcnt(0)" ::: "memory"); __builtin_amdgcn_s_barrier(); asm volatile("" ::: "memory");
        const int f0 = u.pn * 128 + wc * 32 + 8 * fq;
        const int row0 = u.pm * BM + wr * 64 + fr;
#pragma unroll
        for (int n = 0; n < 2; ++n) {
            const f32x4 w0 = *(const f32x4*)(cw + f0 + 4 * n), w1 = *(const f32x4*)(cw + DFF + f0 + 4 * n), w2 = *(const f32x4*)(cw + 2 * DFF + f0 + 4 * n), bv = *(const f32x4*)(cb + f0 + 4 * n);
#pragma unroll
            for (int ai = 0; ai < 2; ++ai) { const int q = 2 * ai + wr;
                f32x4 hup = {0.f, 0.f, 0.f, 0.f}, hdn = hup;
                if (q > 0) hup = *(const LAS f32x4*)(EX + (((q - 1) * 2 + 1) * 4 + wc) * 32 + 8 * fq + 4 * n);
                if (q < 3) hdn = *(const LAS f32x4*)(EX + (((q + 1) * 2 + 0) * 4 + wc) * 32 + 8 * fq + 4 * n);
#pragma unroll
                for (int m = 0; m < 4; ++m) {
                    const f32x4 a = acc[ai][0][m][n], g = acc[ai][1][m][n];
                    f32x4 c;
#pragma unroll
                    for (int j = 0; j < 4; ++j) {
                        const float t1 = __shfl(a[j], lane - 1), t2 = (m > 0) ? __shfl(acc[ai][0][m > 0 ? m - 1 : 0][n][j], lane + 15) : hup[j];
                        const float d1 = __shfl(a[j], lane + 1), d2 = (m < 3) ? __shfl(acc[ai][0][m < 3 ? m + 1 : 3][n][j], lane - 15) : hdn[j];
                        const float up = (fr == 0) ? t2 : t1, dn = (fr == 15) ? d2 : d1;
                        c[j] = w0[j] * up + w1[j] * a[j] + w2[j] * dn + bv[j]; }
                    const f32x2 g0 = gelu_pk((f32x2){c[0], c[1]}), g1 = gelu_pk((f32x2){c[2], c[3]});
                    u32x2 w; w.x = cvt_pk_bf16(g0.x * g[0], g0.y * g[1]); w.y = cvt_pk_bf16(g1.x * g[2], g1.y * g[3]);
                    *(u32x2*)(U2 + (size_t)(row0 + ai * HALF + m * 16) * DFF + f0 + 4 * n) = w;
                    if ((q == 0 && m == 0 && fr == 0) || (q == 3 && m == 3 && fr == 15)) { const size_t eo = ((size_t)(u.pm * 2 + (q == 3 ? 1 : 0))) * DFF + f0 + 4 * n;
                        *(f32x4*)(AE + eo) = a; *(f32x4*)(CP + eo) = c; *(f32x4*)(GP + eo) = g; }
                }
            }
        }
    }
};
struct OrdZ { int G, c, n, shift;
    __device__ __forceinline__ bool next(int i, Unit& u) const { u.kb = 0; u.nt = 0; const int L = i * G + c; if (L >= n) return false; const int q = n / 8, xcd = L % 8, off = L / 8, w = xcd * q + off; u.z = w >> shift; u.pm = w & ((1 << shift) - 1); u.pn = 0; return true; } };
struct EpiF2 {
    static constexpr bool PERM = true;
    bf16_t* O; int roff;
    __device__ __forceinline__ bool keep(const Unit&) const { return false; }
    __device__ __forceinline__ void operator()(Acc& acc, const Unit& u, int wr, int wc, int fr, int fq) const {
        const int b = u.z >> 3, gq = u.z & 7;
        bf16_t* base = O + (size_t)(b * LT + roff + u.pm * 256 + wr * 64 + fr) * BW + gq * 256 + wc * 32 + 8 * fq;
#pragma unroll
        for (int ai = 0; ai < 2; ++ai)
#pragma unroll
            for (int m = 0; m < 4; ++m)
#pragma unroll
                for (int bj = 0; bj < 2; ++bj) { const f32x4 v0 = acc[ai][bj][m][0], v1 = acc[ai][bj][m][1];
                    u32x4 w; w.x = cvt_pk_bf16(v0[0], v0[1]); w.y = cvt_pk_bf16(v0[2], v0[3]); w.z = cvt_pk_bf16(v1[0], v1[1]); w.w = cvt_pk_bf16(v1[2], v1[3]);
                    *(u32x4*)(base + (size_t)(ai * 128 + m * 16) * BW + bj * 128) = w; }
    }
};
}

namespace att {
constexpr int D = 128, NW = 8, QBLK = 32, KVBLK = 64;
constexpr float SCALE = 0.088388347648318440f;
constexpr float THR = 8.f;
constexpr int LDQ = N1, LDK = 128, LDO = BW;
constexpr size_t SHM_V = KVBLK * D * 2, SHM_K = KVBLK * D * 2, SHM_ATTN = 2 * SHM_V + 2 * SHM_K + NW * 64 * 4;
#define KSWZ(row, colB) ((row) * 256 + ((colB) ^ (((row) & 7) << 4)))
#define SBAR() __builtin_amdgcn_sched_barrier(0)
__device__ __forceinline__ int crow(int r, int hi) { return (r & 3) + 8 * (r >> 2) + 4 * hi; }
__device__ __forceinline__ unsigned cvtpk(float lo, float hi) { unsigned r; asm volatile("v_cvt_pk_bf16_f32 %0, %1, %2" : "=v"(r) : "v"(lo), "v"(hi)); return r; }
__device__ __forceinline__ void partialSM(f32x16& p0, f32x16& p1, float& m_reg, float& mn, float& alpha) {
  constexpr float C = SCALE * 1.4426950408889634f;
  float pmax = p0[0];
#pragma unroll
  for (int r = 1; r < 16; ++r) pmax = fmaxf(pmax, p0[r]);
#pragma unroll
  for (int r = 0; r < 16; ++r) pmax = fmaxf(pmax, p1[r]);
  { auto rr = __builtin_amdgcn_permlane32_swap(__float_as_uint(pmax), __float_as_uint(pmax), false, false);
    pmax = fmaxf(__uint_as_float(rr[0]), __uint_as_float(rr[1])); }
  if (__builtin_expect(__all(pmax - m_reg <= THR / SCALE), 1)) { mn = m_reg; alpha = 1.f; }
  else { mn = fmaxf(m_reg, pmax); alpha = __builtin_amdgcn_exp2f((m_reg - mn) * C); m_reg = mn; }
  float mnC = -mn * C;
#pragma unroll
  for (int r = 0; r < 16; ++r) p0[r] = fmaf(p0[r], C, mnC);
#pragma unroll
  for (int r = 0; r < 16; ++r) p1[r] = fmaf(p1[r], C, mnC);
#pragma unroll
  for (int r = 0; r < 16; ++r) p0[r] = __builtin_amdgcn_exp2f(p0[r]);
}
__device__ __forceinline__ void finishSM(f32x16& p0, f32x16& p1, float alpha, float& l_reg, bf16x8& pa0, bf16x8& pa1, bf16x8& pa2, bf16x8& pa3) {
#pragma unroll
  for (int r = 0; r < 16; ++r) p1[r] = __builtin_amdgcn_exp2f(p1[r]);
  float ps = 0;
#pragma unroll
  for (int r = 0; r < 16; ++r) ps += p0[r];
#pragma unroll
  for (int r = 0; r < 16; ++r) ps += p1[r];
  { auto rr = __builtin_amdgcn_permlane32_swap(__float_as_uint(ps), __float_as_uint(ps), false, false);
    ps = __uint_as_float(rr[0]) + __uint_as_float(rr[1]); }
  l_reg = l_reg * alpha + ps;
#define PK4(P, BASE, OUT) do { unsigned a0 = cvtpk(P[BASE + 0], P[BASE + 1]), a1 = cvtpk(P[BASE + 2], P[BASE + 3]);   \
    unsigned b0 = cvtpk(P[BASE + 4], P[BASE + 5]), b1 = cvtpk(P[BASE + 6], P[BASE + 7]);                              \
    auto r0 = __builtin_amdgcn_permlane32_swap(a0, b0, false, false); auto r1 = __builtin_amdgcn_permlane32_swap(a1, b1, false, false); \
    u32x4 w = {r0[0], r1[0], r0[1], r1[1]}; OUT = *reinterpret_cast<bf16x8*>(&w); } while (0)
  PK4(p0, 0, pa0); PK4(p0, 8, pa1); PK4(p1, 0, pa2); PK4(p1, 8, pa3);
#undef PK4
}
__device__ __forceinline__ void qkt(f32x16& p0, f32x16& p1, const bf16_t* Ks, const bf16x8* qr, int r32, int hi) {
  p0 = f32x16{}; p1 = f32x16{};
#pragma unroll
  for (int d0 = 0; d0 < 8; ++d0) { int cb = (d0 * 16 + hi * 8) * 2;
    bf16x8 b0 = *reinterpret_cast<const bf16x8*>((const char*)Ks + KSWZ(r32, cb));
    bf16x8 b1 = *reinterpret_cast<const bf16x8*>((const char*)Ks + KSWZ(32 + r32, cb));
    p0 = __builtin_amdgcn_mfma_f32_32x32x16_bf16(b0, qr[d0], p0, 0, 0, 0);
    p1 = __builtin_amdgcn_mfma_f32_32x32x16_bf16(b1, qr[d0], p1, 0, 0, 0); }
}
__device__ __forceinline__ int v_st(int k, int c) { const int kk = (k & ~0xC) | ((k & 4) << 1) | ((k & 8) >> 1); return ((kk >> 3) * 4 + (c >> 5)) * 512 + ((kk & 7) * 32 + (c & 31)) * 2; }
__device__ __forceinline__ int v_rd_base(int lane) { return ((lane & 3) << 3) | (((lane >> 2) & 3) << 6) | (((lane >> 4) & 1) << 5) | (((lane >> 5) & 1) << 8); }
constexpr int v_rd_off(int d0, int ks, int half) { return d0 * 512 + ks * 4096 + half * 2048; }
template <int OFF> __device__ __forceinline__ s16x4 tr_read(int vb) {
  s16x4 r; asm volatile("ds_read_b64_tr_b16 %0, %1 offset:%2" : "=&v"(r) : "v"(vb), "i"(OFF) : "memory"); return r;
}
template <int D0> __device__ __forceinline__ void pv_one(f32x16& od, int vb, bf16x8 pa0, bf16x8 pa1, bf16x8 pa2, bf16x8 pa3) {
  const s16x4 l0 = tr_read<v_rd_off(D0, 0, 0)>(vb), h0 = tr_read<v_rd_off(D0, 0, 1)>(vb), l1 = tr_read<v_rd_off(D0, 1, 0)>(vb), h1 = tr_read<v_rd_off(D0, 1, 1)>(vb);
  const s16x4 l2 = tr_read<v_rd_off(D0, 2, 0)>(vb), h2 = tr_read<v_rd_off(D0, 2, 1)>(vb), l3 = tr_read<v_rd_off(D0, 3, 0)>(vb), h3 = tr_read<v_rd_off(D0, 3, 1)>(vb);
  asm volatile("s_waitcnt lgkmcnt(0)" ::: "memory"); SBAR();
#define PK(L, H) (bf16x8){L[0], L[1], L[2], L[3], H[0], H[1], H[2], H[3]}
  od = __builtin_amdgcn_mfma_f32_32x32x16_bf16(pa0, PK(l0, h0), od, 0, 0, 0);
  od = __builtin_amdgcn_mfma_f32_32x32x16_bf16(pa1, PK(l1, h1), od, 0, 0, 0);
  od = __builtin_amdgcn_mfma_f32_32x32x16_bf16(pa2, PK(l2, h2), od, 0, 0, 0);
  od = __builtin_amdgcn_mfma_f32_32x32x16_bf16(pa3, PK(l3, h3), od, 0, 0, 0);
#undef PK
}
__device__ __forceinline__ void pv_d0(f32x16* o, int vb, bf16x8 pa0, bf16x8 pa1, bf16x8 pa2, bf16x8 pa3) {
  pv_one<0>(o[0], vb, pa0, pa1, pa2, pa3); pv_one<1>(o[1], vb, pa0, pa1, pa2, pa3); pv_one<2>(o[2], vb, pa0, pa1, pa2, pa3); pv_one<3>(o[3], vb, pa0, pa1, pa2, pa3);
}
__device__ __forceinline__ void attn_dense_body(const bf16_t* __restrict__ Qb, const bf16_t* __restrict__ Kh, const bf16_t* __restrict__ Vh, void* __restrict__ Obv, int OBF, int seq, char* lds) {
  int tid_ = threadIdx.x; asm volatile("" : "+v"(tid_));
  const int tid = tid_, wid = tid >> 6, lane = tid & 63, r32 = lane & 31, hi = lane >> 5;
  bf16_t* V_lds = (bf16_t*)lds; bf16_t* K_lds = (bf16_t*)(lds + 2 * SHM_V);
  float* ws = (float*)(lds + 2 * SHM_V + 2 * SHM_K) + wid * 64; float* li_l = ws; float* al_l = ws + 32;
  float m_reg = -1e30f, l_reg = 0; f32x16 o[4] = {}; bf16x8 qr[8];
  const bf16_t* Qw = Qb + (long)(wid * QBLK + r32) * LDQ + hi * 8;
#pragma unroll
  for (int d0 = 0; d0 < 8; ++d0) qr[d0] = *reinterpret_cast<const bf16x8*>(Qw + d0 * 16);
  const int sr = tid >> 4, sc = (tid & 15) * 8, vst0 = v_st(sr, sc), vst1 = v_st(32 + sr, sc);
  const int vb0 = (int)(uintptr_t)V_lds + v_rd_base(lane);
  struct { bf16x8 vs0, vs1, ks0, ks1; } sr_[2];
#define SLOAD(i, k0) do { sr_[i].vs0 = *reinterpret_cast<const bf16x8*>(&Vh[(long)((k0) + sr) * LDK + sc]); sr_[i].vs1 = *reinterpret_cast<const bf16x8*>(&Vh[(long)((k0) + 32 + sr) * LDK + sc]); \
    sr_[i].ks0 = *reinterpret_cast<const bf16x8*>(&Kh[(long)((k0) + sr) * LDK + sc]); sr_[i].ks1 = *reinterpret_cast<const bf16x8*>(&Kh[(long)((k0) + 32 + sr) * LDK + sc]); } while (0)
#define SWRITE(b, i) do { *(bf16x8*)((char*)V_lds + (b) * SHM_V + vst0) = sr_[i].vs0;          \
    *(bf16x8*)((char*)V_lds + (b) * SHM_V + vst1) = sr_[i].vs1; int kc = sc * 2;               \
    *(bf16x8*)((char*)K_lds + (b) * SHM_K + KSWZ(sr, kc)) = sr_[i].ks0;                       \
    *(bf16x8*)((char*)K_lds + (b) * SHM_K + KSWZ(32 + sr, kc)) = sr_[i].ks1; } while (0)
#define SWAIT() asm volatile("s_waitcnt vmcnt(4)" ::: "memory")
#define RESC(a) do { if (__any((a) < 1.f)) { if (hi == 0) al_l[r32] = (a); asm volatile("s_waitcnt lgkmcnt(0)" ::: "memory"); \
    _Pragma("unroll") for (int d = 0; d < 4; ++d) _Pragma("unroll") for (int r = 0; r < 16; ++r) o[d][r] *= al_l[crow(r, hi)]; } } while (0)
  f32x16 pA0, pA1, pB0, pB1; float mnA, mnB, alA, alB; bf16x8 pa0, pa1, pa2, pa3; const int NT = seq / KVBLK;
  constexpr int SE = 0, SO = 1;
  SLOAD(SE, 0); asm volatile("s_waitcnt vmcnt(0)" ::: "memory"); SWRITE(0, SE); __syncthreads();
  qkt(pA0, pA1, K_lds, qr, r32, hi); partialSM(pA0, pA1, m_reg, mnA, alA);
  SLOAD(SO, KVBLK); if (2 < NT) SLOAD(SE, 2 * KVBLK);
  SWAIT(); SWRITE(1, SO); __syncthreads();
  for (int j = 1; j + 1 < NT; j += 2) {
    SBAR(); qkt(pB0, pB1, (bf16_t*)((char*)K_lds + SHM_K), qr, r32, hi);
    finishSM(pA0, pA1, alA, l_reg, pa0, pa1, pa2, pa3); SBAR();
    SLOAD(SO, (j + 2) * KVBLK); SBAR();
    pv_d0(o, vb0, pa0, pa1, pa2, pa3); partialSM(pB0, pB1, m_reg, mnB, alB);
    __syncthreads(); SWAIT(); SWRITE(0, SE);
    RESC(alB); __syncthreads();
    SBAR(); qkt(pA0, pA1, K_lds, qr, r32, hi);
    finishSM(pB0, pB1, alB, l_reg, pa0, pa1, pa2, pa3); SBAR();
    if (j + 3 < NT) SLOAD(SE, (j + 3) * KVBLK); SBAR();
    pv_d0(o, vb0 + (int)SHM_V, pa0, pa1, pa2, pa3); partialSM(pA0, pA1, m_reg, mnA, alA);
    __syncthreads(); SWAIT(); SWRITE(1, SO);
    RESC(alA); __syncthreads();
  }
  SBAR(); qkt(pB0, pB1, (bf16_t*)((char*)K_lds + SHM_K), qr, r32, hi);
  finishSM(pA0, pA1, alA, l_reg, pa0, pa1, pa2, pa3); SBAR();
  pv_d0(o, vb0, pa0, pa1, pa2, pa3); partialSM(pB0, pB1, m_reg, mnB, alB);
  __syncthreads(); RESC(alB);
  finishSM(pB0, pB1, alB, l_reg, pa0, pa1, pa2, pa3); SBAR();
  pv_d0(o, vb0 + (int)SHM_V, pa0, pa1, pa2, pa3);
  if (hi == 0) li_l[r32] = l_reg; asm volatile("s_waitcnt lgkmcnt(0)" ::: "memory");
  float rli[16];
#pragma unroll
  for (int r = 0; r < 16; ++r) rli[r] = __builtin_amdgcn_rcpf(li_l[crow(r, hi)]);
  if (OBF) {
    bf16_t* Ow = (bf16_t*)Obv + (long)(wid * QBLK) * LDO;
#pragma unroll
    for (int r = 0; r < 16; ++r) { int orow = crow(r, hi);
#pragma unroll
      for (int d0 = 0; d0 < 4; ++d0) Ow[(long)orow * LDO + d0 * 32 + r32] = (bf16_t)f2bf(o[d0][r] * rli[r]); }
  } else {
    float* Ow = (float*)Obv + (long)(wid * QBLK) * LDO;
#pragma unroll
    for (int r = 0; r < 16; ++r) { int orow = crow(r, hi);
#pragma unroll
      for (int d0 = 0; d0 < 4; ++d0) Ow[(long)orow * LDO + d0 * 32 + r32] = o[d0][r] * rli[r]; }
  }
#undef SLOAD
#undef SWRITE
#undef SWAIT
#undef RESC
}
}

struct Args { const float* in[22]; float* out; unsigned char* ws; int ph_lo, ph_hi, li, pad; };
enum { I_X = 0, I_C, I_CTX, I_CCTX, I_WADA, I_BADA, I_WIN, I_LAMBDA, I_SUBLN, I_QKG, I_WBR, I_WGATE, I_BGATE, I_WO, I_LN1G, I_LN1B, I_WUP, I_CONVW, I_CONVB, I_WDOWN, I_LN2G, I_LN2B };

__device__ __forceinline__ const float* inp(int i) { int off = i * 8; asm volatile("" : "+s"(off));
    const GAS float* p = *(const GAS float* const __attribute__((address_space(4)))*)((const __attribute__((address_space(4))) char*)__builtin_amdgcn_kernarg_segment_ptr() + off);
    return (const float*)p; }
#define WSP(T, OFF) ((T*)(wsp + (OFF)))
#define PH_BEGIN size_t zoff_ = 0; asm volatile("" : "+s"(zoff_)); unsigned char* wsp = args.ws + zoff_; int tid_p = threadIdx.x; asm volatile("" : "+v"(tid_p)); const int tid = tid_p, lane = tid_p & 63; (void)tid; (void)lane

template <int MODE>
__device__ __forceinline__ void transpose_item(const float* W, int K, int N, bf16_t* WT, int row_off, LAS float* scr, int item, int lane) {
    const int nblk = N / 32, kb = item / nblk, nb = item - kb * nblk, k0 = 64 * kb, n0 = 32 * nb;
    if (MODE == 1) { const int isg = n0 >= DFF, f = n0 - isg * DFF; row_off = (f >> 7) * 256 + isg * 128 + (f & 127) - n0; }
    const bool il = (MODE == 2) && (n0 < 4096 || (n0 >= 8192 && n0 < 10752));
    float tv[32];
#pragma unroll
    for (int i = 0; i < 32; ++i) { const int kk = 2 * i + (lane >> 5); tv[i] = W[(size_t)(k0 + kk) * N + n0 + (lane & 31)]; }
#pragma unroll
    for (int i = 0; i < 32; ++i) { const int kk = 2 * i + (lane >> 5); scr[kk * 33 + (lane & 31)] = tv[i]; }
    LDS_WAIT(); asm volatile("" ::: "memory");
    const int c = lane & 7;
#pragma unroll
    for (int j = 0; j < 4; ++j) { const int n = (lane >> 3) + 8 * j; const LAS float* s = scr + (8 * c) * 33 + n;
        u32x4 o; o.x = pk2(s[0 * 33], s[1 * 33]); o.y = pk2(s[2 * 33], s[3 * 33]); o.z = pk2(s[4 * 33], s[5 * 33]); o.w = pk2(s[6 * 33], s[7 * 33]);
        int drow = row_off + n0 + n; if (il) { const int cn = n0 + n, d = cn & 127; drow = row_off + (cn & ~127) + 2 * (d & 63) + (d >> 6); }
        *(u32x4*)(WT + (size_t)drow * K + k0 + 8 * c) = o; }
    LDS_WAIT(); asm volatile("" ::: "memory");
}

__device__ __forceinline__ void ln_row(const float* yrow, const float* g, const float* bb, float* Xo, bf16_t* Ho, const float* sc, const float* sh, float* Oo, int lane, const float* yp = nullptr, const float* xrow = nullptr, const float* gate = nullptr) {
    f32x4 v[16]; float s = 0.f;
#pragma unroll
    for (int j = 0; j < 16; ++j) { const int c = 256 * j + 4 * lane;
        if (yp) { f32x4 a = *(const f32x4*)(yp + c);
#pragma unroll
            for (int sp = 1; sp < 8; ++sp) a += *(const f32x4*)(yp + (size_t)sp * 512 * DM + c);
            v[j] = *(const f32x4*)(xrow + c) * DN_ALPHA + *(const f32x4*)(gate + c) * a; }
        else v[j] = *(const f32x4*)(yrow + c);
        s += (v[j].x + v[j].y) + (v[j].z + v[j].w); }
    const float mean = wave_sum(s) * (1.f / DM); float s2 = 0.f;
#pragma unroll
    for (int j = 0; j < 16; ++j) { v[j] = v[j] - mean; s2 += (v[j].x * v[j].x + v[j].y * v[j].y) + (v[j].z * v[j].z + v[j].w * v[j].w); }
    const float rstd = 1.f / sqrtf(wave_sum(s2) * (1.f / DM) + NORM_EPS);
#pragma unroll
    for (int j = 0; j < 16; ++j) { const int c = 256 * j + 4 * lane;
        const f32x4 x = v[j] * rstd * *(const f32x4*)(g + c) + *(const f32x4*)(bb + c);
        if (Xo) *(f32x4*)(Xo + c) = x;
        if (Oo) *(f32x4*)(Oo + c) = x;
        if (Ho) { const f32x4 h = x * (*(const f32x4*)(sc + c) + 1.0f) + *(const f32x4*)(sh + c);
            u32x2 w; w.x = cvt_pk_bf16(h.x, h.y); w.y = cvt_pk_bf16(h.z, h.w); *(u32x2*)(Ho + c) = w; } }
}

__global__ void __launch_bounds__(NTHREADS, 2) fwd(Args args) {
    extern __shared__ __attribute__((aligned(16))) unsigned char lds_raw[];
    LAS unsigned char* lds = (LAS unsigned char*)lds_raw;
    const int tid0 = threadIdx.x, wave = __builtin_amdgcn_readfirstlane(tid0 >> 6);
    const int G = gridDim.x, bx = blockIdx.x;
    const int vcu = (G % 8 == 0) ? (bx % 8) * (G / 8) + bx / 8 : bx;
    const int gw = vcu * NWAVES + wave, NGW = G * NWAVES;
    unsigned* ctl = (unsigned*)(args.ws + WS_CTL);
    for (int u = tid0; u < (LDS_BYTES - LDSCTL_OFF) / 4; u += NTHREADS) ((LAS unsigned*)(lds + LDSCTL_OFF))[u] = 0u;
    __syncthreads();
    XcdBarrier bar; bar.bar = ctl + 4096; bar.x = 0; bar.st = nullptr;
    if (MK_N_LAUNCHES == 1) bar = xcd_barrier_post(ctl + 4096, (volatile LAS unsigned*)(lds + LDSCTL_OFF + 64));
    const int lo = args.ph_lo, hi = args.ph_hi;
#ifndef PHMASK
#define PHMASK 0xFFFFFFFFu
#endif
#define PHB(k) ((PHMASK >> (k)) & 1u)
#ifndef REPMASK
#define REPMASK 0u
#endif
#define REPN(k) (1 + (int)((REPMASK >> (k)) & 1u))
#define REP_BEGIN(k) for (int rep_ = 0; rep_ < REPN(k); ++rep_) {
#define REP_END(k) if (rep_ + 1 < REPN(k)) xcd_barrier(bar); }
#define IN(k) (lo <= (k) && (k) < hi)
#define SEAM(k) do { if (IN(k) && IN((k) + 1)) xcd_barrier(bar); } while (0)

    REP_BEGIN(0)
    if (PHB(0) && IN(0)) {
        PH_BEGIN;
        { LAS float* sv = (LAS float*)lds;
          float* MODP = WSP(float, WS_MODP); const float* pc = inp(I_C); const float* pcc = inp(I_CCTX); const float* wada = inp(I_WADA);
          LAS float* red = (LAS float*)(lds + 49152);
          for (int i = tid; i < 3 * DM; i += NTHREADS) { const int j = i / DM, k = i - j * DM; const float c = (j < 2) ? pc[j * DM + k] : pcc[k]; sv[i] = c * sigmoidf_(c); }
          __syncthreads();
          for (int it = bx; it < 768; it += G) {
              const int l = it / 384, r = it - l * 384, cg = r >> 1, kh = r & 1;
              const float* W = wada + (size_t)l * DM * NADA + cg * 128 + 4 * (lane & 31);
              const int kbase = kh * 2048 + wave * 256 + (lane >> 5);
              f32x4 a0 = {0.f, 0.f, 0.f, 0.f}, a1 = a0, a2 = a0;
#pragma unroll 8
              for (int i = 0; i < 128; ++i) { const int k = kbase + 2 * i; const f32x4 w = *(const f32x4*)(W + (size_t)k * NADA);
                  a0 += w * sv[k]; a1 += w * sv[DM + k]; a2 += w * sv[2 * DM + k]; }
#pragma unroll
              for (int j = 0; j < 4; ++j) { a0[j] += __shfl_xor(a0[j], 32); a1[j] += __shfl_xor(a1[j], 32); a2[j] += __shfl_xor(a2[j], 32); }
              if (lane < 32) { *(LAS f32x4*)(red + (wave * 3 + 0) * 128 + 4 * lane) = a0; *(LAS f32x4*)(red + (wave * 3 + 1) * 128 + 4 * lane) = a1; *(LAS f32x4*)(red + (wave * 3 + 2) * 128 + 4 * lane) = a2; }
              __syncthreads();
              if (tid < 384) { float s = 0.f;
#pragma unroll
                  for (int w8 = 0; w8 < 8; ++w8) s += red[w8 * 384 + tid];
                  const int j = tid >> 7, n = tid & 127;
                  MODP[((size_t)(l * 2 + kh) * 3 + j) * NADA + cg * 128 + n] = s; }
              __syncthreads();
          }
        }
        { LAS float* ct = (LAS float*)lds; LAS float* st = ct + 4096;
          for (int i = tid; i < 4096; i += NTHREADS) { const float a = (float)i * (1.0f / 2048.0f); ct[i] = cospif(a); st[i] = sinpif(a); }
          __syncthreads();
          const int gt = vcu * NTHREADS + tid, NGT = G * NTHREADS;
          bf16_t* FM = WSP(bf16_t, WS_F); bf16_t* FCTX = WSP(bf16_t, WS_FCTX); bf16_t* DC = WSP(bf16_t, WS_DC); float* ROPE = WSP(float, WS_ROPE); float* X = WSP(float, WS_X);
          const float* px = inp(I_X); const float* pctx = inp(I_CTX);
          for (int i = gt; i < 4096 * 1024; i += NGT) { const int np = i >> 10, c8 = (i & 1023) * 8; const bool sn = c8 >= 4096; const int n0 = c8 & 4095;
              float v[8];
#pragma unroll
              for (int e = 0; e < 8; ++e) { const int idx = (np * (n0 + e)) & 4095; v[e] = sn ? -st[idx] * (1.0f / 64.0f) : ct[idx] * (1.0f / 64.0f); }
              u32x4 w; w.x = pk2(v[0], v[1]); w.y = pk2(v[2], v[3]); w.z = pk2(v[4], v[5]); w.w = pk2(v[6], v[7]);
              *(u32x4*)(FM + (size_t)np * 8192 + c8) = w; }
          for (int i = gt; i < 256 * 512; i += NGT) { const int np = i >> 9, c = i & 511; const bool sn = c >= 256; const int idx = ((np * (c & 255)) & 255) * 16;
              FCTX[i] = (bf16_t)f2bf(sn ? -st[idx] * (1.0f / 16.0f) : ct[idx] * (1.0f / 16.0f)); }
          for (int i = gt; i < 512 * 256; i += NGT) { const int r = i >> 8, c = i & 255; const bool sn = r >= 256; const int idx = (((r & 255) * c) & 255) * 16;
              DC[i] = (bf16_t)f2bf(sn ? st[idx] * (1.0f / 16.0f) : ct[idx] * (1.0f / 16.0f)); }
          for (int i = gt; i < 4096 * 64; i += NGT) { const int t = i >> 6, f = i & 63; const float pos = (f < 32) ? (float)(t >> 6) : (float)(t & 63);
              const float inv = exp2f(-(float)(f & 31) * (13.287712379549449f / 32.0f));
              double xr = (double)pos * (double)inv * 0.31830988618379067; xr -= 2.0 * floor(xr * 0.5);
              ROPE[2 * i] = cospif((float)xr); ROPE[2 * i + 1] = sinpif((float)xr); }
          for (int i = gt; i < M * (DM / 4); i += NGT) { const int row = i >> 10, c4 = (i & 1023) * 4; const int b = row / LT, p = row - b * LT;
              const float* src = (p < CTX) ? pctx + ((size_t)(b * CTX + p)) * DM + c4 : px + ((size_t)(b * SEQ + p - CTX)) * DM + c4;
              *(f32x4*)(X + (size_t)row * DM + c4) = *(const f32x4*)src; }
          __syncthreads();
        }
        { LAS float* scr = (LAS float*)(lds + wave * 16384);
          constexpr int IT_IN = 64 * 352, IT_G = 64 * 384, IT_B = 32 * 128, IT_O = 64 * 128, IT_UP = 64 * 688, IT_DN = 172 * 128;
          constexpr int IT_LAYER = IT_IN + IT_G + 3 * IT_B + IT_O + IT_UP + IT_DN;
          const float* p_win = inp(I_WIN); const float* p_wg = inp(I_WGATE); const float* p_wbr = inp(I_WBR); const float* p_wo = inp(I_WO); const float* p_wup = inp(I_WUP); const float* p_wdn = inp(I_WDOWN);
          for (int it = gw; it < NLAYER * IT_LAYER; it += NGW) {
              const int l = it / IT_LAYER; int r = it - l * IT_LAYER;
              unsigned char* wl = wsp + WS_W + (size_t)l * W_LAYER;
              if (r < IT_IN) { transpose_item<2>(p_win + (size_t)l * DM * DIN, DM, DIN, (bf16_t*)(wl + W_1), 0, scr, r, lane); continue; } r -= IT_IN;
              if (r < IT_G) { transpose_item<0>(p_wg + (size_t)l * DM * NGATE, DM, NGATE, (bf16_t*)(wl + W_1), DIN, scr, r, lane); continue; } r -= IT_G;
              if (r < 3 * IT_B) { const int n = r / IT_B; r -= n * IT_B; transpose_item<0>(p_wbr + ((size_t)l * 3 + n) * BW * DM, BW, DM, (bf16_t*)(wl + W_B) + (size_t)n * DM * BW, 0, scr, r, lane); continue; } r -= 3 * IT_B;
              if (r < IT_O) { transpose_item<0>(p_wo + (size_t)l * DM * DM, DM, DM, (bf16_t*)(wl + W_O), 0, scr, r, lane); continue; } r -= IT_O;
              if (r < IT_UP) { transpose_item<1>(p_wup + (size_t)l * DM * NUP, DM, NUP, (bf16_t*)(wl + W_UP), 0, scr, r, lane); continue; } r -= IT_UP;
              transpose_item<0>(p_wdn + (size_t)l * DFF * DM, DFF, DM, (bf16_t*)(wl + W_DN), 0, scr, r, lane);
          }
        }
    }
        REP_END(0)
    SEAM(0);
    REP_BEGIN(1)
    if (PHB(1) && IN(1)) {
        PH_BEGIN;
        const int gt = vcu * NTHREADS + tid, NGT = G * NTHREADS;
        float* MODP = WSP(float, WS_MODP); float* MOD = WSP(float, WS_MOD); const float* X = WSP(float, WS_X); bf16_t* H = WSP(bf16_t, WS_H); const float* bada = inp(I_BADA);
        for (int i = gt; i < NLAYER * 3 * NADA; i += NGT) { const int l = i / (3 * NADA), r = i - l * 3 * NADA, j = r / NADA, n = r - j * NADA;
            MOD[i] = MODP[((size_t)(l * 2 + 0) * 3 + j) * NADA + n] + MODP[((size_t)(l * 2 + 1) * 3 + j) * NADA + n] + bada[l * NADA + n]; }
        for (int i = gt; i < M * (DM / 4); i += NGT) { const int row = i >> 10, c4 = (i & 1023) * 4; const int b = row / LT, p = row - b * LT, j = (p < CTX) ? 2 : b;
            const size_t o0 = ((size_t)(0 * 2 + 0) * 3 + j) * NADA, o1 = ((size_t)(0 * 2 + 1) * 3 + j) * NADA;
            const f32x4 sh = *(const f32x4*)(MODP + o0 + c4) + *(const f32x4*)(MODP + o1 + c4) + *(const f32x4*)(bada + c4);
            const f32x4 sc = *(const f32x4*)(MODP + o0 + DM + c4) + *(const f32x4*)(MODP + o1 + DM + c4) + *(const f32x4*)(bada + DM + c4);
            const f32x4 x = *(const f32x4*)(X + (size_t)row * DM + c4);
            const f32x4 h = x * (sc + 1.0f) + sh;
            u32x2 w; w.x = cvt_pk_bf16(h.x, h.y); w.y = cvt_pk_bf16(h.z, h.w); *(u32x2*)(H + (size_t)row * DM + c4) = w; }
    }
        REP_END(1)
    SEAM(1);

#pragma unroll 1
    for (int l = 0; l < NLAYER; ++l) {
        const int P0 = PH_PRO + l * PH_PER_LAYER;
        const bool lastl = (l == NLAYER - 1);
#define WL (wsp + WS_W + (size_t)l * W_LAYER)
#define MODL (WSP(float, WS_MOD) + (size_t)l * 3 * NADA)
        const float lam_init = 0.8f - 0.6f * expf(-0.3f * (float)l);

        REP_BEGIN(2)
        if (PHB(2) && IN(P0 + 0)) {
            PH_BEGIN;
            pg8::Gemm g{WSP(bf16_t, WS_H), (const bf16_t*)(WL + W_1), DM, DM, DM, 0, 0};
            pg8::TileOrder<1> S; S.init(M / 256, N1 / 256, 1, G, bx, lastl, lastl ? 40 : 0);
            pg8::EpiProj E{WSP(bf16_t, WS_PG), inp(I_BGATE) + (size_t)l * NGATE, inp(I_QKG) + (size_t)l * 2 * 128, WSP(float, WS_ROPE), (LAS float*)(lds + LDS_EX_OFF), WSP(bf16_t, WS_KV)};
            pg8::gemm_phase<pg8::EpiProj, pg8::TileOrder<1>>(lds, g, S, E);
        }
        REP_END(2)
        SEAM(P0 + 0);
        REP_BEGIN(3)
        if (PHB(3) && IN(P0 + 1)) {
            PH_BEGIN;
            bf16_t* PG = WSP(bf16_t, WS_PG);
            { pg8::Gemm g{WSP(bf16_t, WS_DC), PG + C_BU, 256, N1, 256, 0, 256};
              pg8::TileOrder<1> S; S.init(2, M / 256, 8, G, bx);
              pg8::EpiF1 E{WSP(bf16_t, WS_YT), WSP(bf16_t, WS_YTC)};
              pg8::gemm_phase<pg8::EpiF1, pg8::TileOrder<1>>(lds, g, S, E);
            }
        }
        REP_END(3)
        SEAM(P0 + 1);
        REP_BEGIN(4)
        if (PHB(4) && IN(P0 + 2)) {
            PH_BEGIN;
            const bf16_t* PG = WSP(bf16_t, WS_PG); const bf16_t* KVB = WSP(bf16_t, WS_KV); float* OA1 = WSP(float, WS_OA1); float* OA2 = WSP(float, WS_OA2); bf16_t* BR = WSP(bf16_t, WS_BR);
            const float* lp = inp(I_LAMBDA) + (size_t)l * 4 * 128; const float* sgp = inp(I_SUBLN) + (size_t)l * 256;
            for (int pass = 0; pass < (lastl ? 2 : 4); ++pass) {
                const int nit = (pass == 0) ? 512 : (pass == 1) ? 256 : (pass == 2) ? 32 : 16;
                const int c0 = (pass == 3) ? (bx + G - (32 % G)) % G : bx;
                for (int L = c0; L < nit; L += G) {
                    int it = L; if (pass < 2) { const int q = nit / 8; it = (L % 8) * q + L / 8; }
                    const bool grp = (pass & 1);
                    int b, qrow, seq, hsel;
                    if (pass == 0) { b = it >> 8; const int r = it & 255; hsel = (r >> 6) * 4 + ((r >> 4) & 3); qrow = b * LT + CTX + (r & 15) * 256; seq = LT; }
                    else if (pass == 1) { b = it >> 7; hsel = (it >> 4) & 7; qrow = b * LT + CTX + (it & 15) * 256; seq = LT; }
                    else if (pass == 2) { b = it >> 4; hsel = it & 15; qrow = b * LT; seq = CTX; }
                    else { b = it >> 3; hsel = it & 7; qrow = b * LT; seq = CTX; }
                    for (int j = 0; j < (grp ? 4 : 1); ++j) {
                        int qcol, ksl, vsl, ocol; void* Ob;
                        if (!grp) { const int kvh = hsel >> 2; qcol = C_CQ + hsel * 128; ksl = 32 + kvh; vsl = 36 + kvh; ocol = hsel * 128; Ob = (void*)(BR + (size_t)2 * M * BW + (size_t)qrow * BW + ocol); }
                        else { const int mp = j >> 1, vh = j & 1; qcol = C_AQ + hsel * 256 + mp * 128; ksl = hsel * 2 + mp; vsl = 16 + hsel * 2 + vh; ocol = hsel * 256 + vh * 128; Ob = (void*)((mp ? OA2 : OA1) + (size_t)qrow * BW + ocol); }
                        att::attn_dense_body(PG + (size_t)qrow * N1 + qcol, KVB + (size_t)(b * 40 + ksl) * LT * 128, KVB + (size_t)(b * 40 + vsl) * LT * 128, Ob, !grp, seq, (char*)lds_raw);
                        __syncthreads();
                    }
                    if (grp) {
                        VM_WAIT();
                        int lz = tid & 63; asm volatile("" : "+v"(lz));
                        const float d1 = wave_sum(lp[lz] * lp[128 + lz] + lp[64 + lz] * lp[192 + lz]);
                        const float d2 = wave_sum(lp[256 + lz] * lp[384 + lz] + lp[320 + lz] * lp[448 + lz]);
                        const float lam = expf(d1) - expf(d2) + lam_init;
                        const f32x4 sgv = *(const f32x4*)(sgp + 4 * lz) * (1.0f - lam_init);
                        for (int r0 = 0; r0 < 32; r0 += 8) { f32x4 dv[8];
#pragma unroll
                            for (int r = 0; r < 8; ++r) { const size_t off = (size_t)(qrow + wave * 32 + r0 + r) * BW + hsel * 256 + 4 * lz;
                                dv[r] = *(const f32x4*)(OA1 + off) - *(const f32x4*)(OA2 + off) * lam; }
#pragma unroll
                            for (int r = 0; r < 8; ++r) { const size_t off = (size_t)(qrow + wave * 32 + r0 + r) * BW + hsel * 256 + 4 * lz;
                                const f32x4 d = dv[r];
                                const float ss = wave_sum((d.x * d.x + d.y * d.y) + (d.z * d.z + d.w * d.w));
                                const float rr = 1.0f / sqrtf(ss * (1.0f / 256.0f) + NORM_EPS);
                                const f32x4 o = d * rr * sgv;
                                u32x2 w; w.x = cvt_pk_bf16(o.x, o.y); w.y = cvt_pk_bf16(o.z, o.w); *(u32x2*)(BR + off) = w; } }
                    }
                }
            }
            VM_WAIT(); __syncthreads();
            { pg8::Gemm g{WSP(bf16_t, WS_F), WSP(bf16_t, WS_YT), 8192, 8192, 8192, 0, (size_t)256 * 8192};
              pg8::OrdZ S{G, bx, 256, 4};
              pg8::EpiF2 E{BR + (size_t)1 * M * BW, CTX};
              pg8::gemm_phase<pg8::EpiF2, pg8::OrdZ>(lds, g, S, E);
            }
            if (!lastl) {
              pg8::Gemm g{WSP(bf16_t, WS_FCTX), WSP(bf16_t, WS_YTC), 512, 512, 512, 0, (size_t)256 * 512};
              pg8::OrdZ S{G, bx, 16, 0};
              pg8::EpiF2 E{BR + (size_t)1 * M * BW, 0};
              pg8::gemm_phase<pg8::EpiF2, pg8::OrdZ>(lds, g, S, E);
            }
        }
        REP_END(4)
        SEAM(P0 + 2);
        REP_BEGIN(5)
        if (PHB(5) && IN(P0 + 3)) {
            PH_BEGIN;
            pg8::Gemm g{WSP(bf16_t, WS_BR), (const bf16_t*)(WL + W_B), BW, BW, BW, (size_t)M * BW, (size_t)DM * BW};
            pg8::TileOrder<3> S; S.init(M / 256, DM / 256, 1, G, bx, lastl);
            pg8::EpiBranch E{WSP(bf16_t, WS_PG) + C_G, WSP(bf16_t, WS_MB)};
            pg8::gemm_phase<pg8::EpiBranch, pg8::TileOrder<3>>(lds, g, S, E);
        }
        REP_END(5)
        SEAM(P0 + 3);
        REP_BEGIN(6)
        if (PHB(6) && IN(P0 + 4)) {
            PH_BEGIN;
            pg8::Gemm g{WSP(bf16_t, WS_MB), (const bf16_t*)(WL + W_O), DM, DM, DM, 0, 0};
            pg8::EpiResid E{WSP(float, WS_X), WSP(float, WS_Y), MODL + 2 * DM, WSP(float, WS_YP)};
            pg8::SplitOrder S; S.init(G, bx, 8, 8, lastl ? 0 : 256); pg8::gemm_phase<pg8::EpiResid, pg8::SplitOrder, true>(lds, g, S, E);
        }
        REP_END(6)
        SEAM(P0 + 4);
        REP_BEGIN(7)
        if (PHB(7) && IN(P0 + 5)) {
            PH_BEGIN;
            const float* Y = WSP(float, WS_Y); float* X = WSP(float, WS_X); bf16_t* H = WSP(bf16_t, WS_H); const float* modl = MODL; const float* YP = WSP(float, WS_YP);
            const float* g1 = inp(I_LN1G) + (size_t)l * DM; const float* b1 = inp(I_LN1B) + (size_t)l * DM;
            for (int row = gw; row < M; row += NGW) { const int b = row / LT, p = row - b * LT, j = (p < CTX) ? 2 : b;
                if (lastl && p < CTX) continue;
                const bool cp = p < CTX;
                ln_row(Y + (size_t)row * DM, g1, b1, X + (size_t)row * DM, H + (size_t)row * DM, modl + (size_t)j * NADA + 4 * DM, modl + (size_t)j * NADA + 3 * DM, nullptr, lane,
                       cp ? YP + (size_t)(b * 256 + p) * DM : nullptr, X + (size_t)row * DM, modl + (size_t)j * NADA + 2 * DM); }
        }
        REP_END(7)
        SEAM(P0 + 5);
        REP_BEGIN(8)
        if (PHB(8) && IN(P0 + 6)) {
            PH_BEGIN;
            pg8::Gemm g{WSP(bf16_t, WS_H), (const bf16_t*)(WL + W_UP), DM, DM, DM, 0, 0};
            pg8::TileOrder<1> S; S.init(M / 256, NUP / 256, 1, G, bx, lastl);
            pg8::EpiConv E{WSP(bf16_t, WS_U2), inp(I_CONVW) + (size_t)l * 3 * DFF, inp(I_CONVB) + (size_t)l * DFF, WSP(float, WS_AE), WSP(float, WS_CP), WSP(float, WS_GP), (LAS float*)(lds + LDS_EX_OFF)};
            pg8::gemm_phase<pg8::EpiConv, pg8::TileOrder<1>>(lds, g, S, E);
        }
        REP_END(8)
        SEAM(P0 + 6);
        REP_BEGIN(9)
        if (PHB(9) && IN(P0 + 7)) {
            PH_BEGIN;
            bf16_t* U2 = WSP(bf16_t, WS_U2); const float* AE = WSP(float, WS_AE); const float* CP = WSP(float, WS_CP); const float* GP = WSP(float, WS_GP);
            const float* cw = inp(I_CONVW) + (size_t)l * 3 * DFF;
            const int gt = vcu * NTHREADS + tid, NGT = G * NTHREADS;
            for (int idx = gt; idx < 34 * 2 * (DFF / 4); idx += NGT) { const int te = idx / (DFF / 4), f4 = (idx - te * (DFF / 4)) * 4, tile = te >> 1, e = te & 1, pt = tile % 17;
                if (lastl && pt == 0) continue;
                f32x4 c = *(const f32x4*)(CP + (size_t)te * DFF + f4); const f32x4 g = *(const f32x4*)(GP + (size_t)te * DFF + f4);
                if (e == 0 && pt >= 2) c += *(const f32x4*)(cw + f4) * *(const f32x4*)(AE + (size_t)((tile - 1) * 2 + 1) * DFF + f4);
                if (e == 1 && pt >= 1 && pt <= 15) c += *(const f32x4*)(cw + 2 * DFF + f4) * *(const f32x4*)(AE + (size_t)((tile + 1) * 2 + 0) * DFF + f4);
                const f32x2 g0 = gelu_pk((f32x2){c[0], c[1]}), g1 = gelu_pk((f32x2){c[2], c[3]});
                u32x2 w; w.x = cvt_pk_bf16(g0.x * g[0], g0.y * g[1]); w.y = cvt_pk_bf16(g1.x * g[2], g1.y * g[3]);
                *(u32x2*)(U2 + (size_t)(tile * 256 + e * 255) * DFF + f4) = w; }
        }
        REP_END(9)
        SEAM(P0 + 7);
        REP_BEGIN(10)
        if (PHB(10) && IN(P0 + 8)) {
            PH_BEGIN;
            pg8::Gemm g{WSP(bf16_t, WS_U2), (const bf16_t*)(WL + W_DN), DFF, DFF, DFF, 0, 0};
            pg8::EpiResid E{WSP(float, WS_X), WSP(float, WS_Y), MODL + 5 * DM, WSP(float, WS_YP)};
            pg8::SplitOrder S; S.init(G, bx, 22, 20, lastl ? 0 : 256); pg8::gemm_phase<pg8::EpiResid, pg8::SplitOrder, true>(lds, g, S, E);
        }
        REP_END(10)
        SEAM(P0 + 8);
        REP_BEGIN(11)
        if (PHB(11) && IN(P0 + 9)) {
            PH_BEGIN;
            const float* Y = WSP(float, WS_Y); float* X = WSP(float, WS_X); bf16_t* H = WSP(bf16_t, WS_H); float* outp = args.out; const float* YP = WSP(float, WS_YP);
            const float* g2 = inp(I_LN2G) + (size_t)l * DM; const float* b2 = inp(I_LN2B) + (size_t)l * DM;
            const float* modn = WSP(float, WS_MOD) + (size_t)(l + 1 < NLAYER ? l + 1 : l) * 3 * NADA;
            for (int row = gw; row < M; row += NGW) { const int b = row / LT, p = row - b * LT, j = (p < CTX) ? 2 : b;
                if (!lastl) ln_row(Y + (size_t)row * DM, g2, b2, X + (size_t)row * DM, H + (size_t)row * DM, modn + (size_t)j * NADA + 1 * DM, modn + (size_t)j * NADA + 0 * DM, nullptr, lane,
                                   (p < CTX) ? YP + (size_t)(b * 256 + p) * DM : nullptr, X + (size_t)row * DM, MODL + (size_t)j * NADA + 5 * DM);
                else if (p >= CTX) ln_row(Y + (size_t)row * DM, g2, b2, nullptr, nullptr, nullptr, nullptr, outp + ((size_t)(b * SEQ + p - CTX)) * DM, lane); }
        }
        REP_END(11)
        if (!lastl) SEAM(P0 + 9);
    }
#undef IN
#undef SEAM
}

extern "C" void kernel_launch(void* const* d_in, const int* in_sizes, int n_in, void* d_out, int out_size, void* d_ws, size_t ws_size, hipStream_t stream) {
    static int grid = 0;
    if (grid == 0) {
        if (n_in != 22 || in_sizes[0] != NB * SEQ * DM || out_size != NB * SEQ * DM || ws_size < WS_END) {
            fprintf(stderr, "kernel_launch: shape mismatch: n_in %d in0 %d out %d ws %zu (need %zu)\n", n_in, n_in > 0 ? in_sizes[0] : -1, out_size, ws_size, (size_t)WS_END); grid = -1; return; }
        int dev = 0, cus = 0, per_cu = 0;
        if (hipGetDevice(&dev) != hipSuccess || hipDeviceGetAttribute(&cus, hipDeviceAttributeMultiprocessorCount, dev) != hipSuccess) { grid = -1; return; }
        if (hipFuncSetAttribute((const void*)fwd, hipFuncAttributeMaxDynamicSharedMemorySize, LDS_BYTES) != hipSuccess) { fprintf(stderr, "kernel_launch: hipFuncSetAttribute failed\n"); grid = -1; return; }
        if (hipOccupancyMaxActiveBlocksPerMultiprocessor(&per_cu, (const void*)fwd, NTHREADS, LDS_BYTES) != hipSuccess || per_cu < 1) fprintf(stderr, "kernel_launch: occupancy query reports %d\n", per_cu);
        (void)hipGetLastError();
        grid = cus;
    }
    if (grid < 0) return;
    if (hipMemsetAsync((char*)d_ws + WS_CTL, 0, CTL_ZERO_BYTES, stream) != hipSuccess) return;
    Args a{};
    for (int i = 0; i < 22; ++i) a.in[i] = (const float*)d_in[i];
    a.out = (float*)d_out; a.ws = (unsigned char*)d_ws;
    if (MK_N_LAUNCHES == 1) { a.ph_lo = 0; a.ph_hi = NPH; a.li = 0; hipLaunchKernelGGL(fwd, dim3(grid), dim3(NTHREADS), LDS_BYTES, stream, a); }
    else for (int p = 0; p < NPH; ++p) { a.ph_lo = p; a.ph_hi = p + 1; a.li = p; hipLaunchKernelGGL(fwd, dim3(grid), dim3(NTHREADS), LDS_BYTES, stream, a); }
}
```

```cpp
#include <hip/hip_runtime.h>
#include <cstdio>
#include <cstdint>

#ifndef MK_N_LAUNCHES
#define MK_N_LAUNCHES 1
#endif

#define LAS __attribute__((address_space(3)))
#define GAS __attribute__((address_space(1)))
typedef unsigned short bf16_t;
typedef short bf16x8 __attribute__((ext_vector_type(8)));
typedef short s16x4 __attribute__((ext_vector_type(4)));
typedef float f32x2 __attribute__((ext_vector_type(2)));
typedef float f32x4 __attribute__((ext_vector_type(4)));
typedef float f32x16 __attribute__((ext_vector_type(16)));
typedef unsigned u32x2 __attribute__((ext_vector_type(2)));
typedef unsigned u32x4 __attribute__((ext_vector_type(4)));

constexpr int DM = 4096, NB = 2, SEQ = 4096, CTX = 256, LT = SEQ + CTX, M = NB * LT;
constexpr int DIN = 11264, NGATE = 12288, N1 = DIN + NGATE, DFF = 11008, NUP = 2 * DFF, BW = 2048;
constexpr int C_AQ = 0, C_AK = 2048, C_AV = 4096, C_BU = 6144, C_CQ = 8192, C_CK = 10240, C_CV = 10752, C_G = 11264;
constexpr int NLAYER = 2, NADA = 6 * DM;
constexpr float NORM_EPS = 1e-6f;
constexpr float DN_ALPHA = 1.4142135623730951f;
constexpr int NWAVES = 8, NTHREADS = 512;
constexpr int PH_PRO = 2, PH_PER_LAYER = 10, NPH = PH_PRO + NLAYER * PH_PER_LAYER;

constexpr size_t MiB = 1ull << 20;
constexpr size_t WS_CTL = 0, CTL_ZERO_BYTES = 1 * MiB;
constexpr size_t WS_MODP = 1 * MiB;
constexpr size_t WS_MOD = 3 * MiB;
constexpr size_t WS_ROPE = 4 * MiB;
constexpr size_t WS_DC = 6 * MiB;
constexpr size_t WS_FCTX = 6 * MiB + 512 * 1024;
constexpr size_t WS_F = 8 * MiB;
constexpr size_t WS_W = 72 * MiB;
constexpr size_t W_1 = 0, W_B = 184 * MiB, W_O = 232 * MiB, W_UP = 264 * MiB, W_DN = 436 * MiB, W_LAYER = 522 * MiB;
constexpr size_t WS_X = 1116 * MiB;
constexpr size_t WS_Y = 1252 * MiB;
constexpr size_t WS_H = 1388 * MiB;
constexpr size_t WS_MB = 1456 * MiB;
constexpr size_t WS_PG = 1524 * MiB;
constexpr size_t WS_AG = WS_PG;
constexpr size_t WS_OA1 = 1915 * MiB, WS_OA2 = 1983 * MiB;
constexpr size_t WS_BR = 2051 * MiB;
constexpr size_t WS_U2 = WS_OA1;
constexpr size_t WS_YT = 2153 * MiB;
constexpr size_t WS_YTC = 2217 * MiB;
constexpr size_t WS_AE = 2221 * MiB, WS_CP = 2224 * MiB, WS_GP = 2227 * MiB;
constexpr size_t WS_YP = 2230 * MiB;
constexpr size_t WS_KV = 2294 * MiB;
constexpr size_t WS_END = 2380 * MiB;

constexpr int RING_BYTES = 131072, LDSCTL_OFF = RING_BYTES, LDS_EX_OFF = RING_BYTES + 1024, LDS_BYTES = 147456;

#define RLX_AGENT __ATOMIC_RELAXED, __HIP_MEMORY_SCOPE_AGENT
#define LDS_WAIT() asm volatile("s_waitcnt lgkmcnt(0)" ::: "memory")
#define VM_WAIT() asm volatile("s_waitcnt vmcnt(0)" ::: "memory")
__device__ __forceinline__ unsigned f2bf(float f) { unsigned u = __builtin_bit_cast(unsigned, f); return (u + 0x7fffu + ((u >> 16) & 1u)) >> 16; }
__device__ __forceinline__ unsigned pk2(float lo, float hi) { return f2bf(lo) | (f2bf(hi) << 16); }
__device__ __forceinline__ float bflo(unsigned w) { return __builtin_bit_cast(float, w << 16); }
__device__ __forceinline__ float bfhi(unsigned w) { return __builtin_bit_cast(float, w & 0xffff0000u); }
__device__ __forceinline__ unsigned cvt_pk_bf16(float lo, float hi) { unsigned r; asm volatile("v_cvt_pk_bf16_f32 %0, %1, %2" : "=v"(r) : "v"(lo), "v"(hi)); return r; }
__device__ __forceinline__ float wave_sum(float v) {
#pragma unroll
    for (int o = 1; o < 64; o <<= 1) v += __shfl_xor(v, o);
    return v;
}
__device__ __forceinline__ float half_sum(float v) {
#pragma unroll
    for (int o = 1; o < 32; o <<= 1) v += __shfl_xor(v, o);
    return v;
}
__device__ __forceinline__ f32x2 gelu_pk(f32x2 v) {
    const f32x2 av = __builtin_elementwise_abs(v), d = av * 0.2316418882f + 1.0f;
    f32x2 t; t.x = __builtin_amdgcn_rcpf(d.x); t.y = __builtin_amdgcn_rcpf(d.y);
    f32x2 q = t * 0.5307027145f + (-0.7265760135f); q = q * t + 0.7107068705f; q = q * t + (-0.142248368f); q = q * t + 0.127414796f; q = q * t;
    const f32x2 s = (v * v) * (-0.72134752044f);
    f32x2 e; e.x = __builtin_amdgcn_exp2f(s.x); e.y = __builtin_amdgcn_exp2f(s.y);
    const f32x2 m = v * (q * e), r = v - m;
    f32x2 o; o.x = v.x < 0.f ? m.x : r.x; o.y = v.y < 0.f ? m.y : r.y; return o;
}
__device__ __forceinline__ float sigmoidf_(float z) { return __builtin_amdgcn_rcpf(1.0f + __builtin_amdgcn_exp2f(-1.4426950408889634f * z)); }

#define XB_TMO      128
#define XB_XCNT(j)  (256  + 64 * (j))
#define XB_XSUB(j)  (1280 + 64 * (j))
#define XB_XGEN(j)  (2304 + 64 * (j))
#define XB_TOP      3328
#define XB_TOPGEN   3392
#define XCD_BAR_WORDS 3456
#define XB_SPIN_CAP (1u << 18)
__device__ __forceinline__ unsigned xb_ld(unsigned* p)              { return __hip_atomic_load(p, __ATOMIC_RELAXED, __HIP_MEMORY_SCOPE_AGENT); }
__device__ __forceinline__ unsigned xb_add(unsigned* p, unsigned v) { return __hip_atomic_fetch_add(p, v, __ATOMIC_RELAXED, __HIP_MEMORY_SCOPE_AGENT); }
__device__ __forceinline__ unsigned xb_xcc_id() { return (unsigned)__builtin_amdgcn_s_getreg((3 << 11) | 20) & 0xFu; }
#define XB_SPIN(cond, bar) do { unsigned _sp = 0; while (cond) { __builtin_amdgcn_s_sleep(1); \
    if ((++_sp & 255u) == 0u) { if (xb_ld(&(bar)[XB_TMO])) break; if (_sp > XB_SPIN_CAP) { atomicAdd(&(bar)[XB_TMO], 1u); break; } } } } while (0)
struct XcdBarrier { unsigned* bar; unsigned x; volatile LAS unsigned* st; };
__device__ __forceinline__ XcdBarrier xcd_barrier_post(unsigned* bar, volatile LAS unsigned* st) {
    XcdBarrier b; b.bar = bar; b.x = xb_xcc_id(); b.st = st;
    if (threadIdx.x == 0) (void)xb_add(&bar[XB_XCNT(b.x)], 1u);
    return b;
}
__device__ __forceinline__ void xcd_barrier_complete(unsigned* bar, unsigned x, unsigned& nloc, unsigned& nx) {
    const unsigned G = gridDim.x * gridDim.y * gridDim.z;
    unsigned sum, cnt, mine, sp = 0u;
    for (;;) {
        sum = 0u; cnt = 0u; mine = 0u;
#pragma unroll
        for (unsigned j = 0; j < 16; ++j) { const unsigned c = xb_ld(&bar[XB_XCNT(j)]); sum += c; cnt += (c > 0u) ? 1u : 0u; mine = (j == x) ? c : mine; }
        if (sum == G) break;
        __builtin_amdgcn_s_sleep(1);
        if ((++sp & 255u) == 0u) { if (xb_ld(&bar[XB_TMO])) break; if (sp > XB_SPIN_CAP) { atomicAdd(&bar[XB_TMO], 1u); break; } }
    }
    nloc = mine > 0u ? mine : 1u; nx = cnt > 0u ? cnt : 1u;
}
__device__ __forceinline__ void xcd_barrier(const XcdBarrier& b) {
    asm volatile("s_waitcnt vmcnt(0)" ::: "memory");
    __syncthreads();
    if (threadIdx.x == 0) {
        unsigned* bar = b.bar;
        __builtin_amdgcn_s_waitcnt(0);
        unsigned nloc = b.st[0], nx = b.st[1];
        if (nloc == 0u) { xcd_barrier_complete(bar, b.x, nloc, nx); b.st[0] = nloc; b.st[1] = nx; }
        const unsigned old = xb_add(&bar[XB_XSUB(b.x)], 1u);
        const unsigned gen = old / nloc;
        if (old + 1u == (gen + 1u) * nloc) {
            __builtin_amdgcn_fence(__ATOMIC_RELEASE, "agent");
            asm volatile("s_waitcnt vmcnt(0)" ::: "memory");
            const unsigned og = xb_add(&bar[XB_TOP], 1u);
            const unsigned tg = og / nx;
            if (og + 1u == (tg + 1u) * nx) xb_add(&bar[XB_TOPGEN], 1u);
            else XB_SPIN(xb_ld(&bar[XB_TOPGEN]) == tg, bar);
            __builtin_amdgcn_fence(__ATOMIC_ACQUIRE, "agent");
            xb_add(&bar[XB_XGEN(b.x)], 1u);
            asm volatile("s_waitcnt vmcnt(0)" ::: "memory");
        } else {
            XB_SPIN(xb_ld(&bar[XB_XGEN(b.x)]) == gen, bar);
            __builtin_amdgcn_fence(__ATOMIC_ACQUIRE, "agent");
            asm volatile("s_waitcnt vmcnt(0)" ::: "memory");
        }
    }
    __syncthreads();
}

namespace pg8 {
constexpr int BM = 256, BK = 64, HALF = 128, HTB = HALF * BK * 2, STAGE_BYTES = 8 * HTB, NXCD = 8, WGM = 8;
__host__ __device__ __forceinline__ int lds_byte(int r, int c) { const int st = (r >> 4) * 2 + (c >> 5), rr = r & 15, cc = c & 31, ob = rr * 64 + cc * 2; return st * 1024 + (ob ^ (((ob >> 9) & 1) << 5)); }
__host__ __device__ __forceinline__ void stage_rc(int b, int& R, int& C) { const int st = b / 1024, sb = b % 1024, swz = sb ^ (((sb >> 9) & 1) << 5); R = (st >> 1) * 16 + swz / 64; C = (st & 1) * 32 + (swz % 64) / 2; }
__host__ __device__ __forceinline__ int perm32(int rho) { const int n = rho >> 4, i = rho & 15; return 8 * (i >> 2) + 4 * n + (i & 3); }

struct Unit { int pm, pn, z, kb, nt; };
struct Gemm { const bf16_t* A; const bf16_t* Bt; int lda, ldb, K; size_t zA, zB; };

template <int SEG> struct TileOrder {
    int nM, nN, nz, nwg, G, c, lat, nextra;
    __device__ __forceinline__ void init(int nM_, int nN_, int nz_, int G_, int c_, int lat_ = 0, int nextra_ = 0) { lat = lat_; nextra = nextra_; nM = lat ? 32 : nM_; nN = nN_; nz = nz_; nwg = nM * nN * nz; G = G_; c = c_; }
    __device__ __forceinline__ bool next(int i, Unit& u) const {
        const int ti = i / SEG, sg = i - ti * SEG;
        const long L = (long)ti * G + c; if (L >= nwg + nextra) return false;
        u.kb = 0; u.nt = 0;
        if (L >= nwg) { const int idx = (int)L - nwg, t = idx / 20, j = idx - t * 20; u.pm = t * 17; u.pn = j < 16 ? 8 + j : 24 + j; u.z = 0; return true; }
        int wgid = (int)L; { const int q = nwg / NXCD, r = nwg % NXCD, xcd = wgid % NXCD, off = wgid / NXCD; wgid = (xcd < r ? xcd * (q + 1) : r * (q + 1) + (xcd - r) * q) + off; }
        const int per = nM * nN, zz = wgid / per; wgid -= zz * per;
        const int nig = WGM * nN, gid = wgid / nig, fm = gid * WGM, gsz = (nM - fm) < WGM ? (nM - fm) : WGM;
        int pm = fm + ((wgid % nig) % gsz); if (lat) pm += 1 + (pm >= 16);
        u.pm = pm; u.pn = (wgid % nig) / gsz; u.z = (SEG > 1) ? sg : zz; return true;
    }
};

struct SplitOrder { int G, c, nta, ntb, nsub;
    __device__ __forceinline__ void init(int G_, int c_, int nta_, int ntb_, int nsub_) { G = G_; c = c_; nta = nta_; ntb = ntb_; nsub = nsub_; }
    __device__ __forceinline__ bool next(int i, Unit& u) const {
        const int L = i * G + c;
        const bool ok = L < 512 + nsub;
        const int w = (L & 7) * 64 + (L >> 3);
        const int gid = w >> 7, r = w & 127; int pm_l = gid * 8 + (r & 7); pm_l += 1 + (pm_l >= 16); const int pn_l = r >> 3;
        const int idx = L - 512, tile = idx >> 3, sp = idx & 7;
        const bool lat = L < 512;
        const int pm = lat ? pm_l : (tile >> 4) * 17, pn = lat ? pn_l : (tile & 15), z = lat ? 0 : sp;
        const int nt = lat ? 0 : (sp < 6 ? nta : ntb), kb = lat ? 0 : (sp < 6 ? sp * nta : 6 * nta + (sp - 6) * ntb) * BK;
        u.pm = pm; u.pn = pn; u.z = z; u.kb = kb; u.nt = nt;
        return ok;
    }
};

template <class Epi, class Sched, bool VARK = false, bool ALIGN_EPI = true, bool SP2 = true>
__device__ __forceinline__ void gemm_phase(LAS unsigned char* lds, const Gemm g, const Sched& S, const Epi& E) {
    int tid_ = threadIdx.x; asm volatile("" : "+v"(tid_));
    const int tid = tid_, wid = __builtin_amdgcn_readfirstlane(tid >> 6), lane = tid & 63, wr = wid >> 2, wc = wid & 3, fr = lane & 15, fq = lane >> 4;
    const int ntf = g.K / BK;
    unsigned voffA[2], voffB[2];
#pragma unroll
    for (int i = 0; i < 2; ++i) { int R, C; stage_rc(tid * 16 + i * 8192, R, C); const int Rb = Epi::PERM ? ((R & ~31) + perm32(R & 31)) : R;
        voffA[i] = (unsigned)(R * g.lda + C) * 2u; voffB[i] = (unsigned)(Rb * g.ldb + C) * 2u; }
    const size_t kstep = (size_t)(BK * 2);
    const size_t hstepA = (size_t)HALF * g.lda * 2, hstepB = (size_t)HALF * g.ldb * 2;
    const size_t tstepA = 2 * hstepA, tstepB = 2 * hstepB;
    const unsigned ldsw = (unsigned)wid * 1024u;
    const int aoff = lds_byte(wr * 64 + fr, fq * 8), boff = lds_byte(wc * 32 + fr, fq * 8);
#define PG8_SA(b, h) (((b) * 2 + (h)) * HTB)
#define PG8_SB(b, h) ((4 + (b) * 2 + (h)) * HTB)
#define PG8_STAGE(bufoff, gbase, voff) do { _Pragma("unroll") for (int _i = 0; _i < 2; ++_i) \
        __builtin_amdgcn_global_load_lds((const unsigned*)((const char*)(gbase) + (voff)[_i]), (LAS unsigned*)(lds + (bufoff) + ldsw + _i * 8192), 16, 0, 0); } while (0)
#define PG8_LDA(dst, b, h) do { _Pragma("unroll") for (int m = 0; m < 4; ++m) _Pragma("unroll") for (int k = 0; k < 2; ++k) dst[m][k] = *(const LAS bf16x8*)(lds + PG8_SA(b, h) + aoff + m * 2048 + k * 1024); } while (0)
#define PG8_LDB(dst, b, h) do { _Pragma("unroll") for (int n = 0; n < 2; ++n) _Pragma("unroll") for (int k = 0; k < 2; ++k) dst[n][k] = *(const LAS bf16x8*)(lds + PG8_SB(b, h) + boff + n * 2048 + k * 1024); } while (0)
#define PG8_MMA(ai, bj, At, Bt) do { __builtin_amdgcn_s_setprio(1); _Pragma("unroll") for (int m = 0; m < 4; ++m) _Pragma("unroll") for (int n = 0; n < 2; ++n) _Pragma("unroll") for (int k = 0; k < 2; ++k) \
        acc[ai][bj][m][n] = __builtin_amdgcn_mfma_f32_16x16x32_bf16(Bt[n][k], At[m][k], acc[ai][bj][m][n], 0, 0, 0); __builtin_amdgcn_s_setprio(0); } while (0)
#define PG8_WAIT_V(n) asm volatile("s_waitcnt vmcnt(" #n ")" ::: "memory")
#define PG8_WAIT_L(n) asm volatile("s_waitcnt lgkmcnt(" #n ")" ::: "memory")
#define PG8_BAR __builtin_amdgcn_s_barrier()
#define PG8_SCHED __builtin_amdgcn_sched_barrier(0)
    Unit cur{0, 0, 0, 0, 0}, nxt{0, 0, 0, 0, 0}; int ui = 0;
    if (!S.next(0, cur)) return;
    f32x4 acc[2][2][4][2];
#pragma unroll
    for (int a = 0; a < 2; ++a)
#pragma unroll
        for (int b = 0; b < 2; ++b)
#pragma unroll
            for (int m = 0; m < 4; ++m)
#pragma unroll
                for (int n = 0; n < 2; ++n) acc[a][b][m][n] = (f32x4){0.f, 0.f, 0.f, 0.f};
    bf16x8 At[4][2], B0[2][2], B1[2][2];
    const char* cA = (const char*)g.A + ((size_t)cur.z * g.zA + (VARK ? cur.kb : 0)) * 2 + (size_t)cur.pm * tstepA; const char* cB = (const char*)g.Bt + ((size_t)cur.z * g.zB + (VARK ? cur.kb : 0)) * 2 + (size_t)cur.pn * tstepB;
    if constexpr (SP2) {
        PG8_STAGE(PG8_SB(0, 0), cB, voffB); PG8_STAGE(PG8_SB(0, 1), cB + hstepB, voffB); PG8_STAGE(PG8_SA(0, 0), cA, voffA); PG8_STAGE(PG8_SA(0, 1), cA + hstepA, voffA);
        if (wr == 1) PG8_BAR;
        PG8_WAIT_V(2); PG8_BAR;
        PG8_STAGE(PG8_SB(1, 0), cB + kstep, voffB); PG8_STAGE(PG8_SA(1, 0), cA + kstep, voffA); PG8_STAGE(PG8_SB(1, 1), cB + hstepB + kstep, voffB);
        PG8_WAIT_V(6); PG8_BAR;
    } else {
        PG8_STAGE(PG8_SB(0, 0), cB, voffB); PG8_STAGE(PG8_SA(0, 0), cA, voffA); PG8_STAGE(PG8_SB(0, 1), cB + hstepB, voffB); PG8_STAGE(PG8_SA(0, 1), cA + hstepA, voffA);
        if (wr == 1) PG8_BAR;
        PG8_WAIT_V(4); PG8_BAR;
        PG8_STAGE(PG8_SB(1, 0), cB + kstep, voffB); PG8_STAGE(PG8_SA(1, 0), cA + kstep, voffA); PG8_STAGE(PG8_SB(1, 1), cB + hstepB + kstep, voffB);
        PG8_WAIT_V(6); PG8_BAR;
    }
#pragma unroll 1
    for (;;) {
        const bool has_next = S.next(ui + 1, nxt);
        const char* nA = has_next ? (const char*)g.A + ((size_t)nxt.z * g.zA + (VARK ? nxt.kb : 0)) * 2 + (size_t)nxt.pm * tstepA : cA;
        const char* nB = has_next ? (const char*)g.Bt + ((size_t)nxt.z * g.zB + (VARK ? nxt.kb : 0)) * 2 + (size_t)nxt.pn * tstepB : cB;
        const int nt = (VARK && cur.nt) ? cur.nt : ntf;
#pragma unroll 1
        for (int t = 0; t < nt; t += 2) {
            const bool last = (t == nt - 2);
            const char* a1 = cA + (size_t)(t + 1) * kstep;
            const char* a2 = last ? nA : cA + (size_t)(t + 2) * kstep; const char* b2 = last ? nB : cB + (size_t)(t + 2) * kstep;
            const char* a3 = a2 + kstep; const char* b3 = b2 + kstep;
            if constexpr (SP2) {
            PG8_LDB(B0, 0, 0); PG8_LDB(B1, 0, 1); PG8_SCHED; PG8_LDA(At, 0, 0); PG8_STAGE(PG8_SA(1, 1), a1 + hstepA, voffA);
            PG8_WAIT_V(8); PG8_WAIT_L(0); PG8_BAR; PG8_MMA(0, 0, At, B0); PG8_MMA(0, 1, At, B1); PG8_BAR; PG8_SCHED;
            PG8_LDA(At, 0, 1); PG8_STAGE(PG8_SB(0, 0), b2, voffB); PG8_STAGE(PG8_SB(0, 1), b2 + hstepB, voffB); PG8_STAGE(PG8_SA(0, 0), a2, voffA);
            PG8_WAIT_V(8); PG8_WAIT_L(0); PG8_BAR; PG8_MMA(1, 0, At, B0); PG8_MMA(1, 1, At, B1); PG8_BAR; PG8_SCHED;
            PG8_LDB(B0, 1, 0); PG8_LDB(B1, 1, 1); PG8_SCHED; PG8_LDA(At, 1, 0); PG8_STAGE(PG8_SA(0, 1), a2 + hstepA, voffA);
            PG8_WAIT_V(8); PG8_WAIT_L(0); PG8_BAR; PG8_MMA(0, 0, At, B0); PG8_MMA(0, 1, At, B1); PG8_BAR; PG8_SCHED;
            PG8_LDA(At, 1, 1); PG8_STAGE(PG8_SB(1, 0), b3, voffB); PG8_STAGE(PG8_SB(1, 1), b3 + hstepB, voffB); PG8_STAGE(PG8_SA(1, 0), a3, voffA);
            PG8_WAIT_V(8); PG8_WAIT_L(0); PG8_BAR; PG8_MMA(1, 0, At, B0); PG8_MMA(1, 1, At, B1); PG8_BAR; PG8_SCHED;
            } else {
            PG8_LDB(B0, 0, 0); PG8_SCHED; PG8_LDA(At, 0, 0); PG8_STAGE(PG8_SA(1, 1), a1 + hstepA, voffA);
            PG8_WAIT_L(8); PG8_BAR; PG8_WAIT_L(0); PG8_MMA(0, 0, At, B0); PG8_BAR; PG8_SCHED;
            PG8_LDB(B1, 0, 1); PG8_STAGE(PG8_SB(0, 0), b2, voffB);
            PG8_BAR; PG8_WAIT_L(0); PG8_MMA(0, 1, At, B1); PG8_BAR;
            PG8_LDA(At, 0, 1); PG8_STAGE(PG8_SA(0, 0), a2, voffA);
            PG8_BAR; PG8_WAIT_L(0); PG8_MMA(1, 0, At, B0); PG8_BAR; PG8_SCHED;
            PG8_STAGE(PG8_SB(0, 1), b2 + hstepB, voffB);
            PG8_WAIT_V(6); PG8_BAR; PG8_MMA(1, 1, At, B1); PG8_BAR;
            PG8_LDB(B0, 1, 0); PG8_SCHED; PG8_LDA(At, 1, 0); PG8_STAGE(PG8_SA(0, 1), a2 + hstepA, voffA);
            PG8_WAIT_L(8); PG8_BAR; PG8_WAIT_L(0); PG8_MMA(0, 0, At, B0); PG8_BAR; PG8_SCHED;
            PG8_LDB(B1, 1, 1); PG8_STAGE(PG8_SB(1, 0), b3, voffB);
            PG8_BAR; PG8_WAIT_L(0); PG8_MMA(0, 1, At, B1); PG8_BAR;
            PG8_LDA(At, 1, 1); PG8_STAGE(PG8_SA(1, 0), a3, voffA);
            PG8_BAR; PG8_WAIT_L(0); PG8_MMA(1, 0, At, B0); PG8_BAR; PG8_SCHED;
            PG8_STAGE(PG8_SB(1, 1), b3 + hstepB, voffB);
            PG8_WAIT_V(6); PG8_BAR; PG8_MMA(1, 1, At, B1); PG8_BAR;
            }
        }
        if constexpr (ALIGN_EPI) { if (wr == 0) PG8_BAR; }
        E(acc, cur, wr, wc, fr, fq);
        if (!has_next) break;
        if (!E.keep(cur)) {
#pragma unroll
        for (int a = 0; a < 2; ++a)
#pragma unroll
            for (int b = 0; b < 2; ++b)
#pragma unroll
                for (int m = 0; m < 4; ++m)
#pragma unroll
                    for (int n = 0; n < 2; ++n) acc[a][b][m][n] = (f32x4){0.f, 0.f, 0.f, 0.f};
        }
        cur.pm = nxt.pm; cur.pn = nxt.pn; cur.z = nxt.z; cur.kb = nxt.kb; cur.nt = nxt.nt; cA = nA; cB = nB; ++ui;
        if constexpr (ALIGN_EPI) { if (wr == 1) PG8_BAR; }
    }
    PG8_WAIT_V(0);
    if constexpr (!ALIGN_EPI) { if (wr == 0) PG8_BAR; }
    PG8_BAR;
#undef PG8_SA
#undef PG8_SB
#undef PG8_STAGE
#undef PG8_LDA
#undef PG8_LDB
#undef PG8_MMA
#undef PG8_WAIT_V
#undef PG8_WAIT_L
#undef PG8_BAR
#undef PG8_SCHED
}

typedef f32x4 Acc[2][2][4][2];

struct EpiBf16 {
    static constexpr bool PERM = true;
    bf16_t* O; int ldc; size_t zO; int row_off; const float* bias; int sig_pn0;
    __device__ __forceinline__ bool keep(const Unit&) const { return false; }
    __device__ __forceinline__ void operator()(Acc& acc, const Unit& u, int wr, int wc, int fr, int fq) const {
        const int row0 = row_off + u.pm * BM + wr * 64 + fr, col0 = u.pn * BM + wc * 32 + 8 * fq;
        bf16_t* base = O + (size_t)u.z * zO;
        const bool sig = u.pn >= sig_pn0;
        f32x4 bv[2][2];
#pragma unroll
        for (int bj = 0; bj < 2; ++bj)
#pragma unroll
            for (int n = 0; n < 2; ++n) bv[bj][n] = sig ? *(const f32x4*)(bias + (col0 - sig_pn0 * BM) + bj * HALF + 4 * n) : (f32x4){0.f, 0.f, 0.f, 0.f};
#pragma unroll
        for (int ai = 0; ai < 2; ++ai)
#pragma unroll
            for (int m = 0; m < 4; ++m) { bf16_t* rowp = base + (size_t)(row0 + ai * HALF + m * 16) * ldc + col0;
#pragma unroll
                for (int bj = 0; bj < 2; ++bj) { f32x4 v0 = acc[ai][bj][m][0], v1 = acc[ai][bj][m][1];
                    if (sig) { v0 += bv[bj][0]; v1 += bv[bj][1];
#pragma unroll
                        for (int j = 0; j < 4; ++j) { v0[j] = sigmoidf_(v0[j]); v1[j] = sigmoidf_(v1[j]); } }
                    u32x4 w; w.x = cvt_pk_bf16(v0[0], v0[1]); w.y = cvt_pk_bf16(v0[2], v0[3]); w.z = cvt_pk_bf16(v1[0], v1[1]); w.w = cvt_pk_bf16(v1[2], v1[3]);
                    *(u32x4*)(rowp + bj * HALF) = w; } }
    }
};
struct EpiF1 {
    static constexpr bool PERM = true;
    bf16_t* YT; bf16_t* YTC;
    __device__ __forceinline__ bool keep(const Unit&) const { return false; }
    __device__ __forceinline__ void operator()(Acc& acc, const Unit& u, int wr, int wc, int fr, int fq) const {
        const int b = u.pn / 17, pt = u.pn - b * 17;
        const int cp0 = wr * 64 + fr, tk0 = wc * 32 + 8 * fq;
        bf16_t* base; int ld;
        if (pt == 0) { base = YTC + ((size_t)(b * 8 + u.z) * 256) * 512 + u.pm * 256; ld = 512; }
        else { base = YT + ((size_t)(b * 8 + u.z) * 256) * 8192 + u.pm * 4096 + (pt - 1) * 256; ld = 8192; }
#pragma unroll
        for (int ai = 0; ai < 2; ++ai)
#pragma unroll
            for (int m = 0; m < 4; ++m) { bf16_t* rowp = base + (size_t)(cp0 + ai * HALF + m * 16) * ld + tk0;
#pragma unroll
                for (int bj = 0; bj < 2; ++bj) { const f32x4 v0 = acc[ai][bj][m][0], v1 = acc[ai][bj][m][1];
                    u32x4 w; w.x = cvt_pk_bf16(v0[0], v0[1]); w.y = cvt_pk_bf16(v0[2], v0[3]); w.z = cvt_pk_bf16(v1[0], v1[1]); w.w = cvt_pk_bf16(v1[2], v1[3]);
                    *(u32x4*)(rowp + bj * HALF) = w; } }
    }
};
struct EpiBranch {
    static constexpr bool PERM = true;
    const bf16_t* G; bf16_t* O;
    __device__ __forceinline__ bool keep(const Unit& u) const { return u.z < 2; }
    __device__ __forceinline__ void operator()(Acc& acc, const Unit& u, int wr, int wc, int fr, int fq) const {
        const int row0 = u.pm * BM + wr * 64 + fr, col0 = u.pn * BM + wc * 32 + 8 * fq;
#pragma unroll
        for (int ai = 0; ai < 2; ++ai)
#pragma unroll
            for (int m = 0; m < 4; ++m) { const size_t row = (size_t)(row0 + ai * HALF + m * 16);
#pragma unroll
                for (int bj = 0; bj < 2; ++bj) {
                    const u32x4 ga = *(const u32x4*)(G + row * N1 + u.z * DM + col0 + bj * HALF);
                    float s[8] = {bflo(ga.x), bfhi(ga.x), bflo(ga.y), bfhi(ga.y), bflo(ga.z), bfhi(ga.z), bflo(ga.w), bfhi(ga.w)};
                    if (u.z < 2) { const u32x4 gb = *(const u32x4*)(G + row * N1 + (u.z + 1) * DM + col0 + bj * HALF);
                        const float d[8] = {bflo(gb.x), bfhi(gb.x), bflo(gb.y), bfhi(gb.y), bflo(gb.z), bfhi(gb.z), bflo(gb.w), bfhi(gb.w)};
#pragma unroll
                        for (int j = 0; j < 8; ++j) s[j] = fmaxf(s[j], 1e-20f) * __builtin_amdgcn_rcpf(fmaxf(d[j], 1e-20f)); }
                    else {
#pragma unroll
                        for (int j = 0; j < 8; ++j) s[j] = fmaxf(s[j], 1e-20f); }
                    f32x4 v0 = acc[ai][bj][m][0], v1 = acc[ai][bj][m][1];
#pragma unroll
                    for (int j = 0; j < 4; ++j) { v0[j] *= s[j]; v1[j] *= s[4 + j]; }
                    acc[ai][bj][m][0] = v0; acc[ai][bj][m][1] = v1;
                    if (u.z == 2) { u32x4 w; w.x = cvt_pk_bf16(v0[0], v0[1]); w.y = cvt_pk_bf16(v0[2], v0[3]); w.z = cvt_pk_bf16(v1[0], v1[1]); w.w = cvt_pk_bf16(v1[2], v1[3]);
                        *(u32x4*)(O + row * DM + col0 + bj * HALF) = w; } } }
    }
};
struct EpiResid {
    static constexpr bool PERM = false;
    const float* X; float* Y; const float* gate; float* YP; const float* xin_l; const float* xin_c;
    __device__ __forceinline__ bool keep(const Unit&) const { return false; }
    __device__ __forceinline__ void operator()(Acc& acc, const Unit& u, int wr, int wc, int fr, int fq) const {
        const int row0 = u.pm * BM + wr * 64 + fr, col0 = u.pn * BM + wc * 32 + 4 * fq;
        if (u.nt) {
            float* yp = YP + ((size_t)u.z * 512 + (u.pm / 17) * 256 + wr * 64 + fr) * DM + col0;
#pragma unroll
            for (int ai = 0; ai < 2; ++ai)
#pragma unroll
                for (int m = 0; m < 4; ++m)
#pragma unroll
                    for (int bj = 0; bj < 2; ++bj)
#pragma unroll
                        for (int n = 0; n < 2; ++n) *(f32x4*)(yp + (size_t)(ai * HALF + m * 16) * DM + bj * HALF + n * 16) = acc[ai][bj][m][n];
            return; }
        const int b = u.pm / 17, pt = u.pm - b * 17, j = (pt == 0) ? 2 : b;
        const float* xb = xin_l ? (pt == 0 ? xin_c + (size_t)(b * CTX) * DM : xin_l + (size_t)(b * SEQ + (pt - 1) * 256) * DM) : X + (size_t)u.pm * BM * DM;
        const float* gv = gate + (size_t)j * NADA + col0;
        f32x4 gt[2][2];
#pragma unroll
        for (int bj = 0; bj < 2; ++bj)
#pragma unroll
            for (int n = 0; n < 2; ++n) gt[bj][n] = *(const f32x4*)(gv + bj * HALF + n * 16);
#pragma unroll
        for (int ai = 0; ai < 2; ++ai)
#pragma unroll
            for (int m = 0; m < 4; ++m) { const size_t off = (size_t)(row0 + ai * HALF + m * 16) * DM + col0, xoff = (size_t)(wr * 64 + fr + ai * HALF + m * 16) * DM + col0;
#pragma unroll
                for (int bj = 0; bj < 2; ++bj)
#pragma unroll
                    for (int n = 0; n < 2; ++n) { const f32x4 xv = *(const f32x4*)(xb + xoff + bj * HALF + n * 16);
                        *(f32x4*)(Y + off + bj * HALF + n * 16) = xv * DN_ALPHA + gt[bj][n] * acc[ai][bj][m][n]; }
                asm volatile("" ::: "memory"); }
    }
};
struct EpiProj {
    static constexpr bool PERM = true;
    bf16_t* O; const float* bias; const float* qkg; const float* rope; LAS float* EX; bf16_t* KV;
    __device__ __forceinline__ bool keep(const Unit&) const { return false; }
    __device__ __forceinline__ void operator()(Acc& acc, const Unit& u, int wr, int wc, int fr, int fq) const {
        const int row0 = u.pm * BM + wr * 64 + fr, col0 = u.pn * BM + wc * 32 + 8 * fq;
        const int pt = u.pm % 17; const bool lat = pt != 0;
        const int kind = (u.pn < 16) ? 1 : ((u.pn >= 32 && u.pn < 42) ? 2 : ((u.pn >= 44) ? 3 : 0));
        const int i0 = 16 * wc + 4 * fq;
        if (kind == 2) {
#pragma unroll
            for (int ai = 0; ai < 2; ++ai)
#pragma unroll
                for (int m = 0; m < 4; ++m)
#pragma unroll
                    for (int bj = 0; bj < 2; ++bj) { const f32x4 v0 = acc[ai][bj][m][0], v1 = acc[ai][bj][m][1];
                        float ss = (v0[0] * v0[0] + v0[1] * v0[1]) + (v0[2] * v0[2] + v0[3] * v0[3]) + (v1[0] * v1[0] + v1[1] * v1[1]) + (v1[2] * v1[2] + v1[3] * v1[3]);
                        ss += __shfl_xor(ss, 16); ss += __shfl_xor(ss, 32);
                        if (fq == 0) EX[((ai * HALF + wr * 64 + m * 16 + fr) * 2 + bj) * 4 + wc] = ss; }
            asm volatile("s_waitcnt lgkmcnt(0)" ::: "memory"); __builtin_amdgcn_s_barrier(); asm volatile("" ::: "memory");
            const float* gg = qkg + (u.pn >= 40 ? 128 : 0);
            const f32x4 gA = *(const f32x4*)(gg + i0), gB = *(const f32x4*)(gg + 64 + i0);
#pragma unroll
            for (int ai = 0; ai < 2; ++ai)
#pragma unroll
                for (int m = 0; m < 4; ++m)
#pragma unroll
                    for (int bj = 0; bj < 2; ++bj) { const f32x4 p = *(const LAS f32x4*)(EX + ((ai * HALF + wr * 64 + m * 16 + fr) * 2 + bj) * 4);
                        const float r = 1.0f / sqrtf(((p[0] + p[1]) + (p[2] + p[3])) * (1.0f / 128.0f) + NORM_EPS);
                        f32x4 v0 = acc[ai][bj][m][0], v1 = acc[ai][bj][m][1];
                        v0[0] *= r * gA[0]; v0[1] *= r * gB[0]; v0[2] *= r * gA[1]; v0[3] *= r * gB[1];
                        v1[0] *= r * gA[2]; v1[1] *= r * gB[2]; v1[2] *= r * gA[3]; v1[3] *= r * gB[3];
                        acc[ai][bj][m][0] = v0; acc[ai][bj][m][1] = v1; }
        }
        const bool sig = kind == 3;
        f32x4 bv[2][2];
#pragma unroll
        for (int bj = 0; bj < 2; ++bj)
#pragma unroll
            for (int n = 0; n < 2; ++n) bv[bj][n] = sig ? *(const f32x4*)(bias + (col0 - DIN) + bj * HALF + 4 * n) : (f32x4){0.f, 0.f, 0.f, 0.f};
        const bool dorope = lat && (kind == 1 || kind == 2);
        const int t0 = (pt - 1) * 256 + wr * 64 + fr;
        const bool iskv = (u.pn >= 8 && u.pn < 24) || (u.pn >= 40 && u.pn < 44);
        const int slot0 = (u.pn < 24) ? (u.pn - 8) * 2 : 32 + (u.pn - 40) * 2;
        bf16_t* kvb = KV + (((size_t)((u.pm / 17) * 40 + slot0)) * LT + pt * 256 + wr * 64 + fr) * 128 + wc * 32 + 8 * fq;
#pragma unroll
        for (int ai = 0; ai < 2; ++ai)
#pragma unroll
            for (int m = 0; m < 4; ++m) { bf16_t* rowp = O + (size_t)(row0 + ai * HALF + m * 16) * N1 + col0;
                f32x4 cs0 = {1.f, 0.f, 1.f, 0.f}, cs1 = cs0;
                if (dorope) { const float* rp = rope + ((size_t)(t0 + ai * HALF + m * 16) * 64 + i0) * 2; cs0 = *(const f32x4*)rp; cs1 = *(const f32x4*)(rp + 4); }
#pragma unroll
                for (int bj = 0; bj < 2; ++bj) { f32x4 v0 = acc[ai][bj][m][0], v1 = acc[ai][bj][m][1];
                    if (sig) { v0 += bv[bj][0]; v1 += bv[bj][1];
#pragma unroll
                        for (int j = 0; j < 4; ++j) { v0[j] = sigmoidf_(v0[j]); v1[j] = sigmoidf_(v1[j]); } }
                    if (dorope) {
                        const f32x4 a = v0, b = v1;
                        v0[0] = a[0] * cs0[0] - a[1] * cs0[1]; v0[1] = a[1] * cs0[0] + a[0] * cs0[1]; v0[2] = a[2] * cs0[2] - a[3] * cs0[3]; v0[3] = a[3] * cs0[2] + a[2] * cs0[3];
                        v1[0] = b[0] * cs1[0] - b[1] * cs1[1]; v1[1] = b[1] * cs1[0] + b[0] * cs1[1]; v1[2] = b[2] * cs1[2] - b[3] * cs1[3]; v1[3] = b[3] * cs1[2] + b[2] * cs1[3]; }
                    u32x4 w; w.x = cvt_pk_bf16(v0[0], v0[1]); w.y = cvt_pk_bf16(v0[2], v0[3]); w.z = cvt_pk_bf16(v1[0], v1[1]); w.w = cvt_pk_bf16(v1[2], v1[3]);
                    if (iskv) *(u32x4*)(kvb + (size_t)bj * LT * 128 + (size_t)(ai * HALF + m * 16) * 128) = w;
                    else *(u32x4*)(rowp + bj * HALF) = w; } }
    }
};
struct EpiConv {
    static constexpr bool PERM = true;
    bf16_t* U2; const float* cw; const float* cb; float* AE; float* CP; float* GP; LAS float* EX;
    __device__ __forceinline__ bool keep(const Unit&) const { return false; }
    __device__ __forceinline__ void operator()(Acc& acc, const Unit& u, int wr, int wc, int fr, int fq) const {
        const int lane = fr + 16 * fq;
#pragma unroll
        for (int ai = 0; ai < 2; ++ai) { const int q = 2 * ai + wr;
            if (fr == 0) { *(LAS f32x4*)(EX + ((q * 2 + 0) * 4 + wc) * 32 + 8 * fq) = acc[ai][0][0][0]; *(LAS f32x4*)(EX + ((q * 2 + 0) * 4 + wc) * 32 + 8 * fq + 4) = acc[ai][0][0][1]; }
            if (fr == 15) { *(LAS f32x4*)(EX + ((q * 2 + 1) * 4 + wc) * 32 + 8 * fq) = acc[ai][0][3][0]; *(LAS f32x4*)(EX + ((q * 2 + 1) * 4 + wc) * 32 + 8 * fq + 4) = acc[ai][0][3][1]; } }
        asm volatile("s_waitcnt lgkmcnt(0)" ::: "memory"); __builtin_amdgcn_s_barrier(); asm volatile("" ::: "memory");
        const int f0 = u.pn * 128 + wc * 32 + 8 * fq;
        const int row0 = u.pm * BM + wr * 64 + fr;
#pragma unroll
        for (int n = 0; n < 2; ++n) {
            const f32x4 w0 = *(const f32x4*)(cw + f0 + 4 * n), w1 = *(const f32x4*)(cw + DFF + f0 + 4 * n), w2 = *(const f32x4*)(cw + 2 * DFF + f0 + 4 * n), bv = *(const f32x4*)(cb + f0 + 4 * n);
#pragma unroll
            for (int ai = 0; ai < 2; ++ai) { const int q = 2 * ai + wr;
                f32x4 hup = {0.f, 0.f, 0.f, 0.f}, hdn = hup;
                if (q > 0) hup = *(const LAS f32x4*)(EX + (((q - 1) * 2 + 1) * 4 + wc) * 32 + 8 * fq + 4 * n);
                if (q < 3) hdn = *(const LAS f32x4*)(EX + (((q + 1) * 2 + 0) * 4 + wc) * 32 + 8 * fq + 4 * n);
#pragma unroll
                for (int m = 0; m < 4; ++m) {
                    const f32x4 a = acc[ai][0][m][n], g = acc[ai][1][m][n];
                    f32x4 c;
#pragma unroll
                    for (int j = 0; j < 4; ++j) {
                        const float t1 = __shfl(a[j], lane - 1), t2 = (m > 0) ? __shfl(acc[ai][0][m > 0 ? m - 1 : 0][n][j], lane + 15) : hup[j];
                        const float d1 = __shfl(a[j], lane + 1), d2 = (m < 3) ? __shfl(acc[ai][0][m < 3 ? m + 1 : 3][n][j], lane - 15) : hdn[j];
                        const float up = (fr == 0) ? t2 : t1, dn = (fr == 15) ? d2 : d1;
                        c[j] = w0[j] * up + w1[j] * a[j] + w2[j] * dn + bv[j]; }
                    const f32x2 g0 = gelu_pk((f32x2){c[0], c[1]}), g1 = gelu_pk((f32x2){c[2], c[3]});
                    u32x2 w; w.x = cvt_pk_bf16(g0.x * g[0], g0.y * g[1]); w.y = cvt_pk_bf16(g1.x * g[2], g1.y * g[3]);
                    *(u32x2*)(U2 + (size_t)(row0 + ai * HALF + m * 16) * DFF + f0 + 4 * n) = w;
                    if ((q == 0 && m == 0 && fr == 0) || (q == 3 && m == 3 && fr == 15)) { const size_t eo = ((size_t)(u.pm * 2 + (q == 3 ? 1 : 0))) * DFF + f0 + 4 * n;
                        *(f32x4*)(AE + eo) = a; *(f32x4*)(CP + eo) = c; *(f32x4*)(GP + eo) = g; }
                }
            }
        }
    }
};
struct OrdZ { int G, c, n, shift;
    __device__ __forceinline__ bool next(int i, Unit& u) const { u.kb = 0; u.nt = 0; const int L = i * G + c; if (L >= n) return false; const int q = n / 8, xcd = L % 8, off = L / 8, w = xcd * q + off; u.z = w >> shift; u.pm = w & ((1 << shift) - 1); u.pn = 0; return true; } };
struct EpiF2 {
    static constexpr bool PERM = true;
    bf16_t* O; int roff;
    __device__ __forceinline__ bool keep(const Unit&) const { return false; }
    __device__ __forceinline__ void operator()(Acc& acc, const Unit& u, int wr, int wc, int fr, int fq) const {
        const int b = u.z >> 3, gq = u.z & 7;
        bf16_t* base = O + (size_t)(b * LT + roff + u.pm * 256 + wr * 64 + fr) * BW + gq * 256 + wc * 32 + 8 * fq;
#pragma unroll
        for (int ai = 0; ai < 2; ++ai)
#pragma unroll
            for (int m = 0; m < 4; ++m)
#pragma unroll
                for (int bj = 0; bj < 2; ++bj) { const f32x4 v0 = acc[ai][bj][m][0], v1 = acc[ai][bj][m][1];
                    u32x4 w; w.x = cvt_pk_bf16(v0[0], v0[1]); w.y = cvt_pk_bf16(v0[2], v0[3]); w.z = cvt_pk_bf16(v1[0], v1[1]); w.w = cvt_pk_bf16(v1[2], v1[3]);
                    *(u32x4*)(base + (size_t)(ai * 128 + m * 16) * BW + bj * 128) = w; }
    }
};
}

namespace att {
constexpr int D = 128, NW = 8, QBLK = 32, KVBLK = 64;
constexpr float SCALE = 0.088388347648318440f;
constexpr float THR = 8.f;
constexpr int LDQ = N1, LDK = 128, LDO = BW;
constexpr size_t SHM_V = KVBLK * D * 2, SHM_K = KVBLK * D * 2, SHM_ATTN = 2 * SHM_V + 2 * SHM_K + NW * 64 * 4;
#define KSWZ(row, colB) ((row) * 256 + ((colB) ^ (((row) & 7) << 4)))
#define SBAR() __builtin_amdgcn_sched_barrier(0)
__device__ __forceinline__ int crow(int r, int hi) { return (r & 3) + 8 * (r >> 2) + 4 * hi; }
__device__ __forceinline__ unsigned cvtpk(float lo, float hi) { unsigned r; asm volatile("v_cvt_pk_bf16_f32 %0, %1, %2" : "=v"(r) : "v"(lo), "v"(hi)); return r; }
__device__ __forceinline__ void partialSM(f32x16& p0, f32x16& p1, float& m_reg, float& mn, float& alpha) {
  constexpr float C = SCALE * 1.4426950408889634f;
  float pmax = p0[0];
#pragma unroll
  for (int r = 1; r < 16; ++r) pmax = fmaxf(pmax, p0[r]);
#pragma unroll
  for (int r = 0; r < 16; ++r) pmax = fmaxf(pmax, p1[r]);
  { auto rr = __builtin_amdgcn_permlane32_swap(__float_as_uint(pmax), __float_as_uint(pmax), false, false);
    pmax = fmaxf(__uint_as_float(rr[0]), __uint_as_float(rr[1])); }
  if (__builtin_expect(__all(pmax - m_reg <= THR / SCALE), 1)) { mn = m_reg; alpha = 1.f; }
  else { mn = fmaxf(m_reg, pmax); alpha = __builtin_amdgcn_exp2f((m_reg - mn) * C); m_reg = mn; }
  float mnC = -mn * C;
#pragma unroll
  for (int r = 0; r < 16; ++r) p0[r] = fmaf(p0[r], C, mnC);
#pragma unroll
  for (int r = 0; r < 16; ++r) p1[r] = fmaf(p1[r], C, mnC);
#pragma unroll
  for (int r = 0; r < 16; ++r) p0[r] = __builtin_amdgcn_exp2f(p0[r]);
}
__device__ __forceinline__ void finishSM(f32x16& p0, f32x16& p1, float alpha, float& l_reg, bf16x8& pa0, bf16x8& pa1, bf16x8& pa2, bf16x8& pa3) {
#pragma unroll
  for (int r = 0; r < 16; ++r) p1[r] = __builtin_amdgcn_exp2f(p1[r]);
  float ps = 0;
#pragma unroll
  for (int r = 0; r < 16; ++r) ps += p0[r];
#pragma unroll
  for (int r = 0; r < 16; ++r) ps += p1[r];
  { auto rr = __builtin_amdgcn_permlane32_swap(__float_as_uint(ps), __float_as_uint(ps), false, false);
    ps = __uint_as_float(rr[0]) + __uint_as_float(rr[1]); }
  l_reg = l_reg * alpha + ps;
#define PK4(P, BASE, OUT) do { unsigned a0 = cvtpk(P[BASE + 0], P[BASE + 1]), a1 = cvtpk(P[BASE + 2], P[BASE + 3]);   \
    unsigned b0 = cvtpk(P[BASE + 4], P[BASE + 5]), b1 = cvtpk(P[BASE + 6], P[BASE + 7]);                              \
    auto r0 = __builtin_amdgcn_permlane32_swap(a0, b0, false, false); auto r1 = __builtin_amdgcn_permlane32_swap(a1, b1, false, false); \
    u32x4 w = {r0[0], r1[0], r0[1], r1[1]}; OUT = *reinterpret_cast<bf16x8*>(&w); } while (0)
  PK4(p0, 0, pa0); PK4(p0, 8, pa1); PK4(p1, 0, pa2); PK4(p1, 8, pa3);
#undef PK4
}
__device__ __forceinline__ void qkt(f32x16& p0, f32x16& p1, const bf16_t* Ks, const bf16x8* qr, int r32, int hi) {
  p0 = f32x16{}; p1 = f32x16{};
#pragma unroll
  for (int d0 = 0; d0 < 8; ++d0) { int cb = (d0 * 16 + hi * 8) * 2;
    bf16x8 b0 = *reinterpret_cast<const bf16x8*>((const char*)Ks + KSWZ(r32, cb));
    bf16x8 b1 = *reinterpret_cast<const bf16x8*>((const char*)Ks + KSWZ(32 + r32, cb));
    p0 = __builtin_amdgcn_mfma_f32_32x32x16_bf16(b0, qr[d0], p0, 0, 0, 0);
    p1 = __builtin_amdgcn_mfma_f32_32x32x16_bf16(b1, qr[d0], p1, 0, 0, 0); }
}
__device__ __forceinline__ int v_st(int k, int c) { const int kk = (k & ~0xC) | ((k & 4) << 1) | ((k & 8) >> 1); return ((kk >> 3) * 4 + (c >> 5)) * 512 + ((kk & 7) * 32 + (c & 31)) * 2; }
__device__ __forceinline__ int v_rd_base(int lane) { return ((lane & 3) << 3) | (((lane >> 2) & 3) << 6) | (((lane >> 4) & 1) << 5) | (((lane >> 5) & 1) << 8); }
constexpr int v_rd_off(int d0, int ks, int half) { return d0 * 512 + ks * 4096 + half * 2048; }
template <int OFF> __device__ __forceinline__ s16x4 tr_read(int vb) {
  s16x4 r; asm volatile("ds_read_b64_tr_b16 %0, %1 offset:%2" : "=&v"(r) : "v"(vb), "i"(OFF) : "memory"); return r;
}
template <int D0> __device__ __forceinline__ void pv_one(f32x16& od, int vb, bf16x8 pa0, bf16x8 pa1, bf16x8 pa2, bf16x8 pa3) {
  const s16x4 l0 = tr_read<v_rd_off(D0, 0, 0)>(vb), h0 = tr_read<v_rd_off(D0, 0, 1)>(vb), l1 = tr_read<v_rd_off(D0, 1, 0)>(vb), h1 = tr_read<v_rd_off(D0, 1, 1)>(vb);
  const s16x4 l2 = tr_read<v_rd_off(D0, 2, 0)>(vb), h2 = tr_read<v_rd_off(D0, 2, 1)>(vb), l3 = tr_read<v_rd_off(D0, 3, 0)>(vb), h3 = tr_read<v_rd_off(D0, 3, 1)>(vb);
  asm volatile("s_waitcnt lgkmcnt(0)" ::: "memory"); SBAR();
#define PK(L, H) (bf16x8){L[0], L[1], L[2], L[3], H[0], H[1], H[2], H[3]}
  od = __builtin_amdgcn_mfma_f32_32x32x16_bf16(pa0, PK(l0, h0), od, 0, 0, 0);
  od = __builtin_amdgcn_mfma_f32_32x32x16_bf16(pa1, PK(l1, h1), od, 0, 0, 0);
  od = __builtin_amdgcn_mfma_f32_32x32x16_bf16(pa2, PK(l2, h2), od, 0, 0, 0);
  od = __builtin_amdgcn_mfma_f32_32x32x16_bf16(pa3, PK(l3, h3), od, 0, 0, 0);
#undef PK
}
__device__ __forceinline__ void pv_d0(f32x16* o, int vb, bf16x8 pa0, bf16x8 pa1, bf16x8 pa2, bf16x8 pa3) {
  pv_one<0>(o[0], vb, pa0, pa1, pa2, pa3); pv_one<1>(o[1], vb, pa0, pa1, pa2, pa3); pv_one<2>(o[2], vb, pa0, pa1, pa2, pa3); pv_one<3>(o[3], vb, pa0, pa1, pa2, pa3);
}
__device__ __forceinline__ void attn_dense_body(const bf16_t* __restrict__ Qb, const bf16_t* __restrict__ Kh, const bf16_t* __restrict__ Vh, void* __restrict__ Obv, int OBF, int seq, char* lds) {
  int tid_ = threadIdx.x; asm volatile("" : "+v"(tid_));
  const int tid = tid_, wid = tid >> 6, lane = tid & 63, r32 = lane & 31, hi = lane >> 5;
  bf16_t* V_lds = (bf16_t*)lds; bf16_t* K_lds = (bf16_t*)(lds + 2 * SHM_V);
  float* ws = (float*)(lds + 2 * SHM_V + 2 * SHM_K) + wid * 64; float* li_l = ws; float* al_l = ws + 32;
  float m_reg = -1e30f, l_reg = 0; f32x16 o[4] = {}; bf16x8 qr[8];
  const bf16_t* Qw = Qb + (long)(wid * QBLK + r32) * LDQ + hi * 8;
#pragma unroll
  for (int d0 = 0; d0 < 8; ++d0) qr[d0] = *reinterpret_cast<const bf16x8*>(Qw + d0 * 16);
  const int sr = tid >> 4, sc = (tid & 15) * 8, vst0 = v_st(sr, sc), vst1 = v_st(32 + sr, sc);
  const int vb0 = (int)(uintptr_t)V_lds + v_rd_base(lane);
  struct { bf16x8 vs0, vs1, ks0, ks1; } sr_[2];
#define SLOAD(i, k0) do { sr_[i].vs0 = *reinterpret_cast<const bf16x8*>(&Vh[(long)((k0) + sr) * LDK + sc]); sr_[i].vs1 = *reinterpret_cast<const bf16x8*>(&Vh[(long)((k0) + 32 + sr) * LDK + sc]); \
    sr_[i].ks0 = *reinterpret_cast<const bf16x8*>(&Kh[(long)((k0) + sr) * LDK + sc]); sr_[i].ks1 = *reinterpret_cast<const bf16x8*>(&Kh[(long)((k0) + 32 + sr) * LDK + sc]); } while (0)
#define SWRITE(b, i) do { *(bf16x8*)((char*)V_lds + (b) * SHM_V + vst0) = sr_[i].vs0;          \
    *(bf16x8*)((char*)V_lds + (b) * SHM_V + vst1) = sr_[i].vs1; int kc = sc * 2;               \
    *(bf16x8*)((char*)K_lds + (b) * SHM_K + KSWZ(sr, kc)) = sr_[i].ks0;                       \
    *(bf16x8*)((char*)K_lds + (b) * SHM_K + KSWZ(32 + sr, kc)) = sr_[i].ks1; } while (0)
#define SWAIT() asm volatile("s_waitcnt vmcnt(4)" ::: "memory")
#define RESC(a) do { if (__any((a) < 1.f)) { if (hi == 0) al_l[r32] = (a); asm volatile("s_waitcnt lgkmcnt(0)" ::: "memory"); \
    _Pragma("unroll") for (int d = 0; d < 4; ++d) _Pragma("unroll") for (int r = 0; r < 16; ++r) o[d][r] *= al_l[crow(r, hi)]; } } while (0)
  f32x16 pA0, pA1, pB0, pB1; float mnA, mnB, alA, alB; bf16x8 pa0, pa1, pa2, pa3; const int NT = seq / KVBLK;
  constexpr int SE = 0, SO = 1;
  SLOAD(SE, 0); asm volatile("s_waitcnt vmcnt(0)" ::: "memory"); SWRITE(0, SE); __syncthreads();
  qkt(pA0, pA1, K_lds, qr, r32, hi); partialSM(pA0, pA1, m_reg, mnA, alA);
  SLOAD(SO, KVBLK); if (2 < NT) SLOAD(SE, 2 * KVBLK);
  SWAIT(); SWRITE(1, SO); __syncthreads();
  for (int j = 1; j + 1 < NT; j += 2) {
    SBAR(); qkt(pB0, pB1, (bf16_t*)((char*)K_lds + SHM_K), qr, r32, hi);
    finishSM(pA0, pA1, alA, l_reg, pa0, pa1, pa2, pa3); SBAR();
    SLOAD(SO, (j + 2) * KVBLK); SBAR();
    pv_d0(o, vb0, pa0, pa1, pa2, pa3); partialSM(pB0, pB1, m_reg, mnB, alB);
    __syncthreads(); SWAIT(); SWRITE(0, SE);
    RESC(alB); __syncthreads();
    SBAR(); qkt(pA0, pA1, K_lds, qr, r32, hi);
    finishSM(pB0, pB1, alB, l_reg, pa0, pa1, pa2, pa3); SBAR();
    if (j + 3 < NT) SLOAD(SE, (j + 3) * KVBLK); SBAR();
    pv_d0(o, vb0 + (int)SHM_V, pa0, pa1, pa2, pa3); partialSM(pA0, pA1, m_reg, mnA, alA);
    __syncthreads(); SWAIT(); SWRITE(1, SO);
    RESC(alA); __syncthreads();
  }
  SBAR(); qkt(pB0, pB1, (bf16_t*)((char*)K_lds + SHM_K), qr, r32, hi);
  finishSM(pA0, pA1, alA, l_reg, pa0, pa1, pa2, pa3); SBAR();
  pv_d0(o, vb0, pa0, pa1, pa2, pa3); partialSM(pB0, pB1, m_reg, mnB, alB);
  __syncthreads(); RESC(alB);
  finishSM(pB0, pB1, alB, l_reg, pa0, pa1, pa2, pa3); SBAR();
  pv_d0(o, vb0 + (int)SHM_V, pa0, pa1, pa2, pa3);
  if (hi == 0) li_l[r32] = l_reg; asm volatile("s_waitcnt lgkmcnt(0)" ::: "memory");
  float rli[16];
#pragma unroll
  for (int r = 0; r < 16; ++r) rli[r] = __builtin_amdgcn_rcpf(li_l[crow(r, hi)]);
  if (OBF) {
    bf16_t* Ow = (bf16_t*)Obv + (long)(wid * QBLK) * LDO;
#pragma unroll
    for (int r = 0; r < 16; ++r) { int orow = crow(r, hi);
#pragma unroll
      for (int d0 = 0; d0 < 4; ++d0) Ow[(long)orow * LDO + d0 * 32 + r32] = (bf16_t)f2bf(o[d0][r] * rli[r]); }
  } else {
    float* Ow = (float*)Obv + (long)(wid * QBLK) * LDO;
#pragma unroll
    for (int r = 0; r < 16; ++r) { int orow = crow(r, hi);
#pragma unroll
      for (int d0 = 0; d0 < 4; ++d0) Ow[(long)orow * LDO + d0 * 32 + r32] = o[d0][r] * rli[r]; }
  }
#undef SLOAD
#undef SWRITE
#undef SWAIT
#undef RESC
}
}

struct Args { const float* in[22]; float* out; unsigned char* ws; int ph_lo, ph_hi, li, pad; };
enum { I_X = 0, I_C, I_CTX, I_CCTX, I_WADA, I_BADA, I_WIN, I_LAMBDA, I_SUBLN, I_QKG, I_WBR, I_WGATE, I_BGATE, I_WO, I_LN1G, I_LN1B, I_WUP, I_CONVW, I_CONVB, I_WDOWN, I_LN2G, I_LN2B };

__device__ __forceinline__ const float* inp(int i) { int off = i * 8; asm volatile("" : "+s"(off));
    const GAS float* p = *(const GAS float* const __attribute__((address_space(4)))*)((const __attribute__((address_space(4))) char*)__builtin_amdgcn_kernarg_segment_ptr() + off);
    return (const float*)p; }
#define WSP(T, OFF) ((T*)(wsp + (OFF)))
#define PH_BEGIN size_t zoff_ = 0; asm volatile("" : "+s"(zoff_)); unsigned char* wsp = args.ws + zoff_; int tid_p = threadIdx.x; asm volatile("" : "+v"(tid_p)); const int tid = tid_p, lane = tid_p & 63; (void)tid; (void)lane

template <int MODE>
__device__ __forceinline__ void transpose_item(const float* W, int K, int N, bf16_t* WT, int row_off, LAS float* scr, int item, int lane) {
    const int nblk = N / 32, kb = item / nblk, nb = item - kb * nblk, k0 = 64 * kb, n0 = 32 * nb;
    if (MODE == 1) { const int isg = n0 >= DFF, f = n0 - isg * DFF; row_off = (f >> 7) * 256 + isg * 128 + (f & 127) - n0; }
    const bool il = (MODE == 2) && (n0 < 4096 || (n0 >= 8192 && n0 < 10752));
    float tv[32];
#pragma unroll
    for (int i = 0; i < 32; ++i) { const int kk = 2 * i + (lane >> 5); tv[i] = W[(size_t)(k0 + kk) * N + n0 + (lane & 31)]; }
#pragma unroll
    for (int i = 0; i < 32; ++i) { const int kk = 2 * i + (lane >> 5); scr[kk * 33 + (lane & 31)] = tv[i]; }
    LDS_WAIT(); asm volatile("" ::: "memory");
    const int c = lane & 7;
#pragma unroll
    for (int j = 0; j < 4; ++j) { const int n = (lane >> 3) + 8 * j; const LAS float* s = scr + (8 * c) * 33 + n;
        u32x4 o; o.x = pk2(s[0 * 33], s[1 * 33]); o.y = pk2(s[2 * 33], s[3 * 33]); o.z = pk2(s[4 * 33], s[5 * 33]); o.w = pk2(s[6 * 33], s[7 * 33]);
        int drow = row_off + n0 + n; if (il) { const int cn = n0 + n, d = cn & 127; drow = row_off + (cn & ~127) + 2 * (d & 63) + (d >> 6); }
        *(u32x4*)(WT + (size_t)drow * K + k0 + 8 * c) = o; }
    LDS_WAIT(); asm volatile("" ::: "memory");
}

__device__ __forceinline__ void ln_row(const float* yrow, const float* g, const float* bb, float* Xo, bf16_t* Ho, const float* sc, const float* sh, float* Oo, int lane, const float* yp = nullptr, const float* xrow = nullptr, const float* gate = nullptr) {
    f32x4 v[16]; float s = 0.f;
#pragma unroll
    for (int j = 0; j < 16; ++j) { const int c = 256 * j + 4 * lane;
        if (yp) { f32x4 a = *(const f32x4*)(yp + c);
#pragma unroll
            for (int sp = 1; sp < 8; ++sp) a += *(const f32x4*)(yp + (size_t)sp * 512 * DM + c);
            v[j] = *(const f32x4*)(xrow + c) * DN_ALPHA + *(const f32x4*)(gate + c) * a; }
        else v[j] = *(const f32x4*)(yrow + c);
        s += (v[j].x + v[j].y) + (v[j].z + v[j].w); }
    const float mean = wave_sum(s) * (1.f / DM); float s2 = 0.f;
#pragma unroll
    for (int j = 0; j < 16; ++j) { v[j] = v[j] - mean; s2 += (v[j].x * v[j].x + v[j].y * v[j].y) + (v[j].z * v[j].z + v[j].w * v[j].w); }
    const float rstd = 1.f / sqrtf(wave_sum(s2) * (1.f / DM) + NORM_EPS);
#pragma unroll
    for (int j = 0; j < 16; ++j) { const int c = 256 * j + 4 * lane;
        const f32x4 x = v[j] * rstd * *(const f32x4*)(g + c) + *(const f32x4*)(bb + c);
        if (Xo) *(f32x4*)(Xo + c) = x;
        if (Oo) *(f32x4*)(Oo + c) = x;
        if (Ho) { const f32x4 h = x * (*(const f32x4*)(sc + c) + 1.0f) + *(const f32x4*)(sh + c);
            u32x2 w; w.x = cvt_pk_bf16(h.x, h.y); w.y = cvt_pk_bf16(h.z, h.w); *(u32x2*)(Ho + c) = w; } }
}

__global__ void __launch_bounds__(NTHREADS, 2) fwd(Args args) {
    extern __shared__ __attribute__((aligned(16))) unsigned char lds_raw[];
    LAS unsigned char* lds = (LAS unsigned char*)lds_raw;
    const int tid0 = threadIdx.x, wave = __builtin_amdgcn_readfirstlane(tid0 >> 6);
    const int G = gridDim.x, bx = blockIdx.x;
    const int vcu = (G % 8 == 0) ? (bx % 8) * (G / 8) + bx / 8 : bx;
    const int gw = vcu * NWAVES + wave, NGW = G * NWAVES;
    unsigned* ctl = (unsigned*)(args.ws + WS_CTL);
    for (int u = tid0; u < (LDS_BYTES - LDSCTL_OFF) / 4; u += NTHREADS) ((LAS unsigned*)(lds + LDSCTL_OFF))[u] = 0u;
    __syncthreads();
    XcdBarrier bar; bar.bar = ctl + 4096; bar.x = 0; bar.st = nullptr;
    if (MK_N_LAUNCHES == 1) bar = xcd_barrier_post(ctl + 4096, (volatile LAS unsigned*)(lds + LDSCTL_OFF + 64));
    const int lo = args.ph_lo, hi = args.ph_hi;
#ifndef PHMASK
#define PHMASK 0xFFFFFFFFu
#endif
#define PHB(k) ((PHMASK >> (k)) & 1u)
#ifndef REPMASK
#define REPMASK 0u
#endif
#define REPN(k) (1 + (int)((REPMASK >> (k)) & 1u))
#define REP_BEGIN(k) for (int rep_ = 0; rep_ < REPN(k); ++rep_) {
#define REP_END(k) if (rep_ + 1 < REPN(k)) xcd_barrier(bar); }
#define IN(k) (lo <= (k) && (k) < hi)
#define SEAM(k) do { if (IN(k) && IN((k) + 1)) xcd_barrier(bar); } while (0)

    REP_BEGIN(0)
    if (PHB(0) && IN(0)) {
        PH_BEGIN;
        { LAS float* sv = (LAS float*)lds;
          float* MODP = WSP(float, WS_MODP); const float* pc = inp(I_C); const float* pcc = inp(I_CCTX); const float* wada = inp(I_WADA);
          LAS float* red = (LAS float*)(lds + 49152);
          for (int i = tid; i < 3 * DM; i += NTHREADS) { const int j = i / DM, k = i - j * DM; const float c = (j < 2) ? pc[j * DM + k] : pcc[k]; sv[i] = c * sigmoidf_(c); }
          __syncthreads();
          for (int it = bx; it < 768; it += G) {
              const int l = it / 384, r = it - l * 384, cg = r >> 1, kh = r & 1;
              const float* W = wada + (size_t)l * DM * NADA + cg * 128 + 4 * (lane & 31);
              const int kbase = kh * 2048 + wave * 256 + (lane >> 5);
              f32x4 a0 = {0.f, 0.f, 0.f, 0.f}, a1 = a0, a2 = a0;
#pragma unroll 8
              for (int i = 0; i < 128; ++i) { const int k = kbase + 2 * i; const f32x4 w = *(const f32x4*)(W + (size_t)k * NADA);
                  a0 += w * sv[k]; a1 += w * sv[DM + k]; a2 += w * sv[2 * DM + k]; }
#pragma unroll
              for (int j = 0; j < 4; ++j) { a0[j] += __shfl_xor(a0[j], 32); a1[j] += __shfl_xor(a1[j], 32); a2[j] += __shfl_xor(a2[j], 32); }
              if (lane < 32) { *(LAS f32x4*)(red + (wave * 3 + 0) * 128 + 4 * lane) = a0; *(LAS f32x4*)(red + (wave * 3 + 1) * 128 + 4 * lane) = a1; *(LAS f32x4*)(red + (wave * 3 + 2) * 128 + 4 * lane) = a2; }
              __syncthreads();
              if (tid < 384) { float s = 0.f;
#pragma unroll
                  for (int w8 = 0; w8 < 8; ++w8) s += red[w8 * 384 + tid];
                  const int j = tid >> 7, n = tid & 127;
                  MODP[((size_t)(l * 2 + kh) * 3 + j) * NADA + cg * 128 + n] = s; }
              __syncthreads();
          }
        }
        { LAS float* ct = (LAS float*)lds; LAS float* st = ct + 4096;
          for (int i = tid; i < 4096; i += NTHREADS) { const float a = (float)i * (1.0f / 2048.0f); ct[i] = cospif(a); st[i] = sinpif(a); }
          __syncthreads();
          const int gt = vcu * NTHREADS + tid, NGT = G * NTHREADS;
          bf16_t* FM = WSP(bf16_t, WS_F); bf16_t* FCTX = WSP(bf16_t, WS_FCTX); bf16_t* DC = WSP(bf16_t, WS_DC); float* ROPE = WSP(float, WS_ROPE);
          for (int i = gt; i < 4096 * 1024; i += NGT) { const int np = i >> 10, c8 = (i & 1023) * 8; const bool sn = c8 >= 4096; const int n0 = c8 & 4095;
              float v[8];
#pragma unroll
              for (int e = 0; e < 8; ++e) { const int idx = (np * (n0 + e)) & 4095; v[e] = sn ? -st[idx] * (1.0f / 64.0f) : ct[idx] * (1.0f / 64.0f); }
              u32x4 w; w.x = pk2(v[0], v[1]); w.y = pk2(v[2], v[3]); w.z = pk2(v[4], v[5]); w.w = pk2(v[6], v[7]);
              *(u32x4*)(FM + (size_t)np * 8192 + c8) = w; }
          for (int i = gt; i < 256 * 512; i += NGT) { const int np = i >> 9, c = i & 511; const bool sn = c >= 256; const int idx = ((np * (c & 255)) & 255) * 16;
              FCTX[i] = (bf16_t)f2bf(sn ? -st[idx] * (1.0f / 16.0f) : ct[idx] * (1.0f / 16.0f)); }
          for (int i = gt; i < 512 * 256; i += NGT) { const int r = i >> 8, c = i & 255; const bool sn = r >= 256; const int idx = (((r & 255) * c) & 255) * 16;
              DC[i] = (bf16_t)f2bf(sn ? st[idx] * (1.0f / 16.0f) : ct[idx] * (1.0f / 16.0f)); }
          for (int i = gt; i < 4096 * 64; i += NGT) { const int t = i >> 6, f = i & 63; const float pos = (f < 32) ? (float)(t >> 6) : (float)(t & 63);
              const float inv = exp2f(-(float)(f & 31) * (13.287712379549449f / 32.0f));
              double xr = (double)pos * (double)inv * 0.31830988618379067; xr -= 2.0 * floor(xr * 0.5);
              ROPE[2 * i] = cospif((float)xr); ROPE[2 * i + 1] = sinpif((float)xr); }
          __syncthreads();
        }
        { LAS float* scr = (LAS float*)(lds + wave * 16384);
          constexpr int IT_IN = 64 * 352, IT_G = 64 * 384, IT_B = 32 * 128, IT_O = 64 * 128, IT_UP = 64 * 688, IT_DN = 172 * 128;
          constexpr int IT_LAYER = IT_IN + IT_G + 3 * IT_B + IT_O + IT_UP + IT_DN;
          const float* p_win = inp(I_WIN); const float* p_wg = inp(I_WGATE); const float* p_wbr = inp(I_WBR); const float* p_wo = inp(I_WO); const float* p_wup = inp(I_WUP); const float* p_wdn = inp(I_WDOWN);
          for (int it = gw; it < NLAYER * IT_LAYER; it += NGW) {
              const int l = it / IT_LAYER; int r = it - l * IT_LAYER;
              unsigned char* wl = wsp + WS_W + (size_t)l * W_LAYER;
              if (r < IT_IN) { transpose_item<2>(p_win + (size_t)l * DM * DIN, DM, DIN, (bf16_t*)(wl + W_1), 0, scr, r, lane); continue; } r -= IT_IN;
              if (r < IT_G) { transpose_item<0>(p_wg + (size_t)l * DM * NGATE, DM, NGATE, (bf16_t*)(wl + W_1), DIN, scr, r, lane); continue; } r -= IT_G;
              if (r < 3 * IT_B) { const int n = r / IT_B; r -= n * IT_B; transpose_item<0>(p_wbr + ((size_t)l * 3 + n) * BW * DM, BW, DM, (bf16_t*)(wl + W_B) + (size_t)n * DM * BW, 0, scr, r, lane); continue; } r -= 3 * IT_B;
              if (r < IT_O) { transpose_item<0>(p_wo + (size_t)l * DM * DM, DM, DM, (bf16_t*)(wl + W_O), 0, scr, r, lane); continue; } r -= IT_O;
              if (r < IT_UP) { transpose_item<1>(p_wup + (size_t)l * DM * NUP, DM, NUP, (bf16_t*)(wl + W_UP), 0, scr, r, lane); continue; } r -= IT_UP;
              transpose_item<0>(p_wdn + (size_t)l * DFF * DM, DFF, DM, (bf16_t*)(wl + W_DN), 0, scr, r, lane);
          }
        }
    }
        REP_END(0)
    SEAM(0);
    REP_BEGIN(1)
    if (PHB(1) && IN(1)) {
        PH_BEGIN;
        const int gt = vcu * NTHREADS + tid, NGT = G * NTHREADS;
        float* MODP = WSP(float, WS_MODP); float* MOD = WSP(float, WS_MOD); bf16_t* H = WSP(bf16_t, WS_H); const float* bada = inp(I_BADA); const float* px = inp(I_X); const float* pctx = inp(I_CTX);
        for (int i = gt; i < NLAYER * 3 * NADA; i += NGT) { const int l = i / (3 * NADA), r = i - l * 3 * NADA, j = r / NADA, n = r - j * NADA;
            MOD[i] = MODP[((size_t)(l * 2 + 0) * 3 + j) * NADA + n] + MODP[((size_t)(l * 2 + 1) * 3 + j) * NADA + n] + bada[l * NADA + n]; }
        for (int i = gt; i < M * (DM / 4); i += NGT) { const int row = i >> 10, c4 = (i & 1023) * 4; const int b = row / LT, p = row - b * LT, j = (p < CTX) ? 2 : b;
            const size_t o0 = ((size_t)(0 * 2 + 0) * 3 + j) * NADA, o1 = ((size_t)(0 * 2 + 1) * 3 + j) * NADA;
            const f32x4 sh = *(const f32x4*)(MODP + o0 + c4) + *(const f32x4*)(MODP + o1 + c4) + *(const f32x4*)(bada + c4);
            const f32x4 sc = *(const f32x4*)(MODP + o0 + DM + c4) + *(const f32x4*)(MODP + o1 + DM + c4) + *(const f32x4*)(bada + DM + c4);
            const f32x4 x = *(const f32x4*)((p < CTX) ? pctx + ((size_t)(b * CTX + p)) * DM + c4 : px + ((size_t)(b * SEQ + p - CTX)) * DM + c4);
            const f32x4 h = x * (sc + 1.0f) + sh;
            u32x2 w; w.x = cvt_pk_bf16(h.x, h.y); w.y = cvt_pk_bf16(h.z, h.w); *(u32x2*)(H + (size_t)row * DM + c4) = w; }
    }
        REP_END(1)
    SEAM(1);

#pragma unroll 1
    for (int l = 0; l < NLAYER; ++l) {
        const int P0 = PH_PRO + l * PH_PER_LAYER;
        const bool lastl = (l == NLAYER - 1);
#define WL (wsp + WS_W + (size_t)l * W_LAYER)
#define MODL (WSP(float, WS_MOD) + (size_t)l * 3 * NADA)
        const float lam_init = 0.8f - 0.6f * expf(-0.3f * (float)l);

        REP_BEGIN(2)
        if (PHB(2) && IN(P0 + 0)) {
            PH_BEGIN;
            pg8::Gemm g{WSP(bf16_t, WS_H), (const bf16_t*)(WL + W_1), DM, DM, DM, 0, 0};
            pg8::TileOrder<1> S; S.init(M / 256, N1 / 256, 1, G, bx, lastl, lastl ? 40 : 0);
            pg8::EpiProj E{WSP(bf16_t, WS_PG), inp(I_BGATE) + (size_t)l * NGATE, inp(I_QKG) + (size_t)l * 2 * 128, WSP(float, WS_ROPE), (LAS float*)(lds + LDS_EX_OFF), WSP(bf16_t, WS_KV)};
            pg8::gemm_phase<pg8::EpiProj, pg8::TileOrder<1>>(lds, g, S, E);
        }
        REP_END(2)
        SEAM(P0 + 0);
        REP_BEGIN(3)
        if (PHB(3) && IN(P0 + 1)) {
            PH_BEGIN;
            bf16_t* PG = WSP(bf16_t, WS_PG);
            { pg8::Gemm g{WSP(bf16_t, WS_DC), PG + C_BU, 256, N1, 256, 0, 256};
              pg8::TileOrder<1> S; S.init(2, M / 256, 8, G, bx);
              pg8::EpiF1 E{WSP(bf16_t, WS_YT), WSP(bf16_t, WS_YTC)};
              pg8::gemm_phase<pg8::EpiF1, pg8::TileOrder<1>>(lds, g, S, E);
            }
        }
        REP_END(3)
        SEAM(P0 + 1);
        REP_BEGIN(4)
        if (PHB(4) && IN(P0 + 2)) {
            PH_BEGIN;
            const bf16_t* PG = WSP(bf16_t, WS_PG); const bf16_t* KVB = WSP(bf16_t, WS_KV); float* OA1 = WSP(float, WS_OA1); float* OA2 = WSP(float, WS_OA2); bf16_t* BR = WSP(bf16_t, WS_BR);
            const float* lp = inp(I_LAMBDA) + (size_t)l * 4 * 128; const float* sgp = inp(I_SUBLN) + (size_t)l * 256;
            for (int pass = 0; pass < (lastl ? 2 : 4); ++pass) {
                const int nit = (pass == 0) ? 512 : (pass == 1) ? 256 : (pass == 2) ? 32 : 16;
                const int c0 = (pass == 3) ? (bx + G - (32 % G)) % G : bx;
                for (int L = c0; L < nit; L += G) {
                    int it = L; if (pass < 2) { const int q = nit / 8; it = (L % 8) * q + L / 8; }
                    const bool grp = (pass & 1);
                    int b, qrow, seq, hsel;
                    if (pass == 0) { b = it >> 8; const int r = it & 255; hsel = (r >> 6) * 4 + ((r >> 4) & 3); qrow = b * LT + CTX + (r & 15) * 256; seq = LT; }
                    else if (pass == 1) { b = it >> 7; hsel = (it >> 4) & 7; qrow = b * LT + CTX + (it & 15) * 256; seq = LT; }
                    else if (pass == 2) { b = it >> 4; hsel = it & 15; qrow = b * LT; seq = CTX; }
                    else { b = it >> 3; hsel = it & 7; qrow = b * LT; seq = CTX; }
                    for (int j = 0; j < (grp ? 4 : 1); ++j) {
                        int qcol, ksl, vsl, ocol; void* Ob;
                        if (!grp) { const int kvh = hsel >> 2; qcol = C_CQ + hsel * 128; ksl = 32 + kvh; vsl = 36 + kvh; ocol = hsel * 128; Ob = (void*)(BR + (size_t)2 * M * BW + (size_t)qrow * BW + ocol); }
                        else { const int mp = j >> 1, vh = j & 1; qcol = C_AQ + hsel * 256 + mp * 128; ksl = hsel * 2 + mp; vsl = 16 + hsel * 2 + vh; ocol = hsel * 256 + vh * 128; Ob = (void*)((mp ? OA2 : OA1) + (size_t)qrow * BW + ocol); }
                        att::attn_dense_body(PG + (size_t)qrow * N1 + qcol, KVB + (size_t)(b * 40 + ksl) * LT * 128, KVB + (size_t)(b * 40 + vsl) * LT * 128, Ob, !grp, seq, (char*)lds_raw);
                        __syncthreads();
                    }
                    if (grp) {
                        VM_WAIT();
                        int lz = tid & 63; asm volatile("" : "+v"(lz));
                        const float d1 = wave_sum(lp[lz] * lp[128 + lz] + lp[64 + lz] * lp[192 + lz]);
                        const float d2 = wave_sum(lp[256 + lz] * lp[384 + lz] + lp[320 + lz] * lp[448 + lz]);
                        const float lam = expf(d1) - expf(d2) + lam_init;
                        const f32x4 sgv = *(const f32x4*)(sgp + 4 * lz) * (1.0f - lam_init);
                        for (int r0 = 0; r0 < 32; r0 += 8) { f32x4 dv[8];
#pragma unroll
                            for (int r = 0; r < 8; ++r) { const size_t off = (size_t)(qrow + wave * 32 + r0 + r) * BW + hsel * 256 + 4 * lz;
                                dv[r] = *(const f32x4*)(OA1 + off) - *(const f32x4*)(OA2 + off) * lam; }
#pragma unroll
                            for (int r = 0; r < 8; ++r) { const size_t off = (size_t)(qrow + wave * 32 + r0 + r) * BW + hsel * 256 + 4 * lz;
                                const f32x4 d = dv[r];
                                const float ss = wave_sum((d.x * d.x + d.y * d.y) + (d.z * d.z + d.w * d.w));
                                const float rr = 1.0f / sqrtf(ss * (1.0f / 256.0f) + NORM_EPS);
                                const f32x4 o = d * rr * sgv;
                                u32x2 w; w.x = cvt_pk_bf16(o.x, o.y); w.y = cvt_pk_bf16(o.z, o.w); *(u32x2*)(BR + off) = w; } }
                    }
                }
            }
            VM_WAIT(); __syncthreads();
            { pg8::Gemm g{WSP(bf16_t, WS_F), WSP(bf16_t, WS_YT), 8192, 8192, 8192, 0, (size_t)256 * 8192};
              pg8::OrdZ S{G, bx, 256, 4};
              pg8::EpiF2 E{BR + (size_t)1 * M * BW, CTX};
              pg8::gemm_phase<pg8::EpiF2, pg8::OrdZ>(lds, g, S, E);
            }
            if (!lastl) {
              pg8::Gemm g{WSP(bf16_t, WS_FCTX), WSP(bf16_t, WS_YTC), 512, 512, 512, 0, (size_t)256 * 512};
              pg8::OrdZ S{G, bx, 16, 0};
              pg8::EpiF2 E{BR + (size_t)1 * M * BW, 0};
              pg8::gemm_phase<pg8::EpiF2, pg8::OrdZ>(lds, g, S, E);
            }
        }
        REP_END(4)
        SEAM(P0 + 2);
        REP_BEGIN(5)
        if (PHB(5) && IN(P0 + 3)) {
            PH_BEGIN;
            pg8::Gemm g{WSP(bf16_t, WS_BR), (const bf16_t*)(WL + W_B), BW, BW, BW, (size_t)M * BW, (size_t)DM * BW};
            pg8::TileOrder<3> S; S.init(M / 256, DM / 256, 1, G, bx, lastl);
            pg8::EpiBranch E{WSP(bf16_t, WS_PG) + C_G, WSP(bf16_t, WS_MB)};
            pg8::gemm_phase<pg8::EpiBranch, pg8::TileOrder<3>>(lds, g, S, E);
        }
        REP_END(5)
        SEAM(P0 + 3);
        REP_BEGIN(6)
        if (PHB(6) && IN(P0 + 4)) {
            PH_BEGIN;
            pg8::Gemm g{WSP(bf16_t, WS_MB), (const bf16_t*)(WL + W_O), DM, DM, DM, 0, 0};
            pg8::EpiResid E{WSP(float, WS_X), WSP(float, WS_Y), MODL + 2 * DM, WSP(float, WS_YP), (l == 0) ? inp(I_X) : nullptr, inp(I_CTX)};
            pg8::SplitOrder S; S.init(G, bx, 8, 8, lastl ? 0 : 256); pg8::gemm_phase<pg8::EpiResid, pg8::SplitOrder, true>(lds, g, S, E);
        }
        REP_END(6)
        SEAM(P0 + 4);
        REP_BEGIN(7)
        if (PHB(7) && IN(P0 + 5)) {
            PH_BEGIN;
            const float* Y = WSP(float, WS_Y); float* X = WSP(float, WS_X); bf16_t* H = WSP(bf16_t, WS_H); const float* modl = MODL; const float* YP = WSP(float, WS_YP); const float* ctxin = inp(I_CTX);
            const float* g1 = inp(I_LN1G) + (size_t)l * DM; const float* b1 = inp(I_LN1B) + (size_t)l * DM;
            for (int row = gw; row < M; row += NGW) { const int b = row / LT, p = row - b * LT, j = (p < CTX) ? 2 : b;
                if (lastl && p < CTX) continue;
                const bool cp = p < CTX;
                ln_row(Y + (size_t)row * DM, g1, b1, X + (size_t)row * DM, H + (size_t)row * DM, modl + (size_t)j * NADA + 4 * DM, modl + (size_t)j * NADA + 3 * DM, nullptr, lane,
                       cp ? YP + (size_t)(b * 256 + p) * DM : nullptr, ctxin + (size_t)(b * CTX + (cp ? p : 0)) * DM, modl + (size_t)j * NADA + 2 * DM); }
        }
        REP_END(7)
        SEAM(P0 + 5);
        REP_BEGIN(8)
        if (PHB(8) && IN(P0 + 6)) {
            PH_BEGIN;
            pg8::Gemm g{WSP(bf16_t, WS_H), (const bf16_t*)(WL + W_UP), DM, DM, DM, 0, 0};
            pg8::TileOrder<1> S; S.init(M / 256, NUP / 256, 1, G, bx, lastl);
            pg8::EpiConv E{WSP(bf16_t, WS_U2), inp(I_CONVW) + (size_t)l * 3 * DFF, inp(I_CONVB) + (size_t)l * DFF, WSP(float, WS_AE), WSP(float, WS_CP), WSP(float, WS_GP), (LAS float*)(lds + LDS_EX_OFF)};
            pg8::gemm_phase<pg8::EpiConv, pg8::TileOrder<1>>(lds, g, S, E);
        }
        REP_END(8)
        SEAM(P0 + 6);
        REP_BEGIN(9)
        if (PHB(9) && IN(P0 + 7)) {
            PH_BEGIN;
            bf16_t* U2 = WSP(bf16_t, WS_U2); const float* AE = WSP(float, WS_AE); const float* CP = WSP(float, WS_CP); const float* GP = WSP(float, WS_GP);
            const float* cw = inp(I_CONVW) + (size_t)l * 3 * DFF;
            const int gt = vcu * NTHREADS + tid, NGT = G * NTHREADS;
            for (int idx = gt; idx < 34 * 2 * (DFF / 4); idx += NGT) { const int te = idx / (DFF / 4), f4 = (idx - te * (DFF / 4)) * 4, tile = te >> 1, e = te & 1, pt = tile % 17;
                if (lastl && pt == 0) continue;
                f32x4 c = *(const f32x4*)(CP + (size_t)te * DFF + f4); const f32x4 g = *(const f32x4*)(GP + (size_t)te * DFF + f4);
                if (e == 0 && pt >= 2) c += *(const f32x4*)(cw + f4) * *(const f32x4*)(AE + (size_t)((tile - 1) * 2 + 1) * DFF + f4);
                if (e == 1 && pt >= 1 && pt <= 15) c += *(const f32x4*)(cw + 2 * DFF + f4) * *(const f32x4*)(AE + (size_t)((tile + 1) * 2 + 0) * DFF + f4);
                const f32x2 g0 = gelu_pk((f32x2){c[0], c[1]}), g1 = gelu_pk((f32x2){c[2], c[3]});
                u32x2 w; w.x = cvt_pk_bf16(g0.x * g[0], g0.y * g[1]); w.y = cvt_pk_bf16(g1.x * g[2], g1.y * g[3]);
                *(u32x2*)(U2 + (size_t)(tile * 256 + e * 255) * DFF + f4) = w; }
        }
        REP_END(9)
        SEAM(P0 + 7);
        REP_BEGIN(10)
        if (PHB(10) && IN(P0 + 8)) {
            PH_BEGIN;
            pg8::Gemm g{WSP(bf16_t, WS_U2), (const bf16_t*)(WL + W_DN), DFF, DFF, DFF, 0, 0};
            pg8::EpiResid E{WSP(float, WS_X), WSP(float, WS_Y), MODL + 5 * DM, WSP(float, WS_YP), nullptr, nullptr};
            pg8::SplitOrder S; S.init(G, bx, 22, 20, lastl ? 0 : 256); pg8::gemm_phase<pg8::EpiResid, pg8::SplitOrder, true>(lds, g, S, E);
        }
        REP_END(10)
        SEAM(P0 + 8);
        REP_BEGIN(11)
        if (PHB(11) && IN(P0 + 9)) {
            PH_BEGIN;
            const float* Y = WSP(float, WS_Y); float* X = WSP(float, WS_X); bf16_t* H = WSP(bf16_t, WS_H); float* outp = args.out; const float* YP = WSP(float, WS_YP);
            const float* g2 = inp(I_LN2G) + (size_t)l * DM; const float* b2 = inp(I_LN2B) + (size_t)l * DM;
            const float* modn = WSP(float, WS_MOD) + (size_t)(l + 1 < NLAYER ? l + 1 : l) * 3 * NADA;
            for (int row = gw; row < M; row += NGW) { const int b = row / LT, p = row - b * LT, j = (p < CTX) ? 2 : b;
                if (!lastl) ln_row(Y + (size_t)row * DM, g2, b2, X + (size_t)row * DM, H + (size_t)row * DM, modn + (size_t)j * NADA + 1 * DM, modn + (size_t)j * NADA + 0 * DM, nullptr, lane,
                                   (p < CTX) ? YP + (size_t)(b * 256 + p) * DM : nullptr, X + (size_t)row * DM, MODL + (size_t)j * NADA + 5 * DM);
                else if (p >= CTX) ln_row(Y + (size_t)row * DM, g2, b2, nullptr, nullptr, nullptr, nullptr, outp + ((size_t)(b * SEQ + p - CTX)) * DM, lane); }
        }
        REP_END(11)
        if (!lastl) SEAM(P0 + 9);
    }
#undef IN
#undef SEAM
}

extern "C" void kernel_launch(void* const* d_in, const int* in_sizes, int n_in, void* d_out, int out_size, void* d_ws, size_t ws_size, hipStream_t stream) {
    static int grid = 0;
    if (grid == 0) {
        if (n_in != 22 || in_sizes[0] != NB * SEQ * DM || out_size != NB * SEQ * DM || ws_size < WS_END) {
            fprintf(stderr, "kernel_launch: shape mismatch: n_in %d in0 %d out %d ws %zu (need %zu)\n", n_in, n_in > 0 ? in_sizes[0] : -1, out_size, ws_size, (size_t)WS_END); grid = -1; return; }
        int dev = 0, cus = 0, per_cu = 0;
        if (hipGetDevice(&dev) != hipSuccess || hipDeviceGetAttribute(&cus, hipDeviceAttributeMultiprocessorCount, dev) != hipSuccess) { grid = -1; return; }
        if (hipFuncSetAttribute((const void*)fwd, hipFuncAttributeMaxDynamicSharedMemorySize, LDS_BYTES) != hipSuccess) { fprintf(stderr, "kernel_launch: hipFuncSetAttribute failed\n"); grid = -1; return; }
        if (hipOccupancyMaxActiveBlocksPerMultiprocessor(&per_cu, (const void*)fwd, NTHREADS, LDS_BYTES) != hipSuccess || per_cu < 1) fprintf(stderr, "kernel_launch: occupancy query reports %d\n", per_cu);
        (void)hipGetLastError();
        grid = cus;
    }
    if (grid < 0) return;
    if (hipMemsetAsync((char*)d_ws + WS_CTL, 0, CTL_ZERO_BYTES, stream) != hipSuccess) return;
    Args a{};
    for (int i = 0; i < 22; ++i) a.in[i] = (const float*)d_in[i];
    a.out = (float*)d_out; a.ws = (unsigned char*)d_ws;
    if (MK_N_LAUNCHES == 1) { a.ph_lo = 0; a.ph_hi = NPH; a.li = 0; hipLaunchKernelGGL(fwd, dim3(grid), dim3(NTHREADS), LDS_BYTES, stream, a); }
    else for (int p = 0; p < NPH; ++p) { a.ph_lo = p; a.ph_hi = p + 1; a.li = p; hipLaunchKernelGGL(fwd, dim3(grid), dim3(NTHREADS), LDS_BYTES, stream, a); }
}
```

```cpp
#include <hip/hip_runtime.h>
#include <cstdio>
#include <cstdint>

#ifndef MK_N_LAUNCHES
#define MK_N_LAUNCHES 1
#endif

#define LAS __attribute__((address_space(3)))
#define GAS __attribute__((address_space(1)))
typedef unsigned short bf16_t;
typedef short bf16x8 __attribute__((ext_vector_type(8)));
typedef short s16x4 __attribute__((ext_vector_type(4)));
typedef float f32x2 __attribute__((ext_vector_type(2)));
typedef float f32x4 __attribute__((ext_vector_type(4)));
typedef float f32x16 __attribute__((ext_vector_type(16)));
typedef unsigned u32x2 __attribute__((ext_vector_type(2)));
typedef unsigned u32x4 __attribute__((ext_vector_type(4)));

constexpr int DM = 4096, NB = 2, SEQ = 4096, CTX = 256, LT = SEQ + CTX, M = NB * LT;
constexpr int DIN = 11264, NGATE = 12288, N1 = DIN + NGATE, DFF = 11008, NUP = 2 * DFF, BW = 2048;
constexpr int C_AQ = 0, C_AK = 2048, C_AV = 4096, C_BU = 6144, C_CQ = 8192, C_CK = 10240, C_CV = 10752, C_G = 11264;
constexpr int NLAYER = 2, NADA = 6 * DM;
constexpr float NORM_EPS = 1e-6f;
constexpr float DN_ALPHA = 1.4142135623730951f;
constexpr int NWAVES = 8, NTHREADS = 512;
constexpr int PH_PRO = 2, PH_PER_LAYER = 10, NPH = PH_PRO + NLAYER * PH_PER_LAYER;

constexpr size_t MiB = 1ull << 20;
constexpr size_t WS_CTL = 0, CTL_ZERO_BYTES = 1 * MiB;
constexpr size_t WS_MODP = 1 * MiB;
constexpr size_t WS_MOD = 3 * MiB;
constexpr size_t WS_ROPE = 4 * MiB;
constexpr size_t WS_DC = 6 * MiB;
constexpr size_t WS_FCTX = 6 * MiB + 512 * 1024;
constexpr size_t WS_F = 8 * MiB;
constexpr size_t WS_W = 72 * MiB;
constexpr size_t W_1 = 0, W_B = 184 * MiB, W_O = 232 * MiB, W_UP = 264 * MiB, W_DN = 436 * MiB, W_LAYER = 522 * MiB;
constexpr size_t WS_X = 1116 * MiB;
constexpr size_t WS_Y = 1252 * MiB;
constexpr size_t WS_H = 1388 * MiB;
constexpr size_t WS_MB = 1456 * MiB;
constexpr size_t WS_PG = 1524 * MiB;
constexpr size_t WS_AG = WS_PG;
constexpr size_t WS_OA1 = 1915 * MiB, WS_OA2 = 1983 * MiB;
constexpr size_t WS_BR = 2051 * MiB;
constexpr size_t WS_U2 = WS_OA1;
constexpr size_t WS_YT = 2153 * MiB;
constexpr size_t WS_YTC = 2217 * MiB;
constexpr size_t WS_AE = 2221 * MiB, WS_CP = 2224 * MiB, WS_GP = 2227 * MiB;
constexpr size_t WS_YP = 2230 * MiB;
constexpr size_t WS_KV = 2294 * MiB;
constexpr size_t WS_END = 2380 * MiB;

constexpr int RING_BYTES = 131072, LDSCTL_OFF = RING_BYTES, LDS_EX_OFF = RING_BYTES + 1024, LDS_BYTES = 147456;

#define RLX_AGENT __ATOMIC_RELAXED, __HIP_MEMORY_SCOPE_AGENT
#define LDS_WAIT() asm volatile("s_waitcnt lgkmcnt(0)" ::: "memory")
#define VM_WAIT() asm volatile("s_waitcnt vmcnt(0)" ::: "memory")
__device__ __forceinline__ unsigned f2bf(float f) { unsigned u = __builtin_bit_cast(unsigned, f); return (u + 0x7fffu + ((u >> 16) & 1u)) >> 16; }
__device__ __forceinline__ unsigned pk2(float lo, float hi) { return f2bf(lo) | (f2bf(hi) << 16); }
__device__ __forceinline__ float bflo(unsigned w) { return __builtin_bit_cast(float, w << 16); }
__device__ __forceinline__ float bfhi(unsigned w) { return __builtin_bit_cast(float, w & 0xffff0000u); }
__device__ __forceinline__ unsigned cvt_pk_bf16(float lo, float hi) { unsigned r; asm volatile("v_cvt_pk_bf16_f32 %0, %1, %2" : "=v"(r) : "v"(lo), "v"(hi)); return r; }
__device__ __forceinline__ float wave_sum(float v) {
#pragma unroll
    for (int o = 1; o < 64; o <<= 1) v += __shfl_xor(v, o);
    return v;
}
__device__ __forceinline__ float half_sum(float v) {
#pragma unroll
    for (int o = 1; o < 32; o <<= 1) v += __shfl_xor(v, o);
    return v;
}
__device__ __forceinline__ f32x2 gelu_pk(f32x2 v) {
    const f32x2 av = __builtin_elementwise_abs(v), d = av * 0.2316418882f + 1.0f;
    f32x2 t; t.x = __builtin_amdgcn_rcpf(d.x); t.y = __builtin_amdgcn_rcpf(d.y);
    f32x2 q = t * 0.5307027145f + (-0.7265760135f); q = q * t + 0.7107068705f; q = q * t + (-0.142248368f); q = q * t + 0.127414796f; q = q * t;
    const f32x2 s = (v * v) * (-0.72134752044f);
    f32x2 e; e.x = __builtin_amdgcn_exp2f(s.x); e.y = __builtin_amdgcn_exp2f(s.y);
    const f32x2 m = v * (q * e), r = v - m;
    f32x2 o; o.x = v.x < 0.f ? m.x : r.x; o.y = v.y < 0.f ? m.y : r.y; return o;
}
__device__ __forceinline__ float sigmoidf_(float z) { return __builtin_amdgcn_rcpf(1.0f + __builtin_amdgcn_exp2f(-1.4426950408889634f * z)); }

#define XB_TMO      128
#define XB_XCNT(j)  (256  + 64 * (j))
#define XB_XSUB(j)  (1280 + 64 * (j))
#define XB_XGEN(j)  (2304 + 64 * (j))
#define XB_TOP      3328
#define XB_TOPGEN   3392
#define XCD_BAR_WORDS 3456
#define XB_SPIN_CAP (1u << 18)
__device__ __forceinline__ unsigned xb_ld(unsigned* p)              { return __hip_atomic_load(p, __ATOMIC_RELAXED, __HIP_MEMORY_SCOPE_AGENT); }
__device__ __forceinline__ unsigned xb_add(unsigned* p, unsigned v) { return __hip_atomic_fetch_add(p, v, __ATOMIC_RELAXED, __HIP_MEMORY_SCOPE_AGENT); }
__device__ __forceinline__ unsigned xb_xcc_id() { return (unsigned)__builtin_amdgcn_s_getreg((3 << 11) | 20) & 0xFu; }
#define XB_SPIN(cond, bar) do { unsigned _sp = 0; while (cond) { __builtin_amdgcn_s_sleep(1); \
    if ((++_sp & 255u) == 0u) { if (xb_ld(&(bar)[XB_TMO])) break; if (_sp > XB_SPIN_CAP) { atomicAdd(&(bar)[XB_TMO], 1u); break; } } } } while (0)
struct XcdBarrier { unsigned* bar; unsigned x; volatile LAS unsigned* st; };
__device__ __forceinline__ XcdBarrier xcd_barrier_post(unsigned* bar, volatile LAS unsigned* st) {
    XcdBarrier b; b.bar = bar; b.x = xb_xcc_id(); b.st = st;
    if (threadIdx.x == 0) (void)xb_add(&bar[XB_XCNT(b.x)], 1u);
    return b;
}
__device__ __forceinline__ void xcd_barrier_complete(unsigned* bar, unsigned x, unsigned& nloc, unsigned& nx) {
    const unsigned G = gridDim.x * gridDim.y * gridDim.z;
    unsigned sum, cnt, mine, sp = 0u;
    for (;;) {
        sum = 0u; cnt = 0u; mine = 0u;
#pragma unroll
        for (unsigned j = 0; j < 16; ++j) { const unsigned c = xb_ld(&bar[XB_XCNT(j)]); sum += c; cnt += (c > 0u) ? 1u : 0u; mine = (j == x) ? c : mine; }
        if (sum == G) break;
        __builtin_amdgcn_s_sleep(1);
        if ((++sp & 255u) == 0u) { if (xb_ld(&bar[XB_TMO])) break; if (sp > XB_SPIN_CAP) { atomicAdd(&bar[XB_TMO], 1u); break; } }
    }
    nloc = mine > 0u ? mine : 1u; nx = cnt > 0u ? cnt : 1u;
}
__device__ __forceinline__ void xcd_barrier(const XcdBarrier& b) {
    asm volatile("s_waitcnt vmcnt(0)" ::: "memory");
    __syncthreads();
    if (threadIdx.x == 0) {
        unsigned* bar = b.bar;
        __builtin_amdgcn_s_waitcnt(0);
        unsigned nloc = b.st[0], nx = b.st[1];
        if (nloc == 0u) { xcd_barrier_complete(bar, b.x, nloc, nx); b.st[0] = nloc; b.st[1] = nx; }
        const unsigned old = xb_add(&bar[XB_XSUB(b.x)], 1u);
        const unsigned gen = old / nloc;
        if (old + 1u == (gen + 1u) * nloc) {
            __builtin_amdgcn_fence(__ATOMIC_RELEASE, "agent");
            asm volatile("s_waitcnt vmcnt(0)" ::: "memory");
            const unsigned og = xb_add(&bar[XB_TOP], 1u);
            const unsigned tg = og / nx;
            if (og + 1u == (tg + 1u) * nx) xb_add(&bar[XB_TOPGEN], 1u);
            else XB_SPIN(xb_ld(&bar[XB_TOPGEN]) == tg, bar);
            __builtin_amdgcn_fence(__ATOMIC_ACQUIRE, "agent");
            xb_add(&bar[XB_XGEN(b.x)], 1u);
            asm volatile("s_waitcnt vmcnt(0)" ::: "memory");
        } else {
            XB_SPIN(xb_ld(&bar[XB_XGEN(b.x)]) == gen, bar);
            __builtin_amdgcn_fence(__ATOMIC_ACQUIRE, "agent");
            asm volatile("s_waitcnt vmcnt(0)" ::: "memory");
        }
    }
    __syncthreads();
}

namespace pg8 {
constexpr int BM = 256, BK = 64, HALF = 128, HTB = HALF * BK * 2, STAGE_BYTES = 8 * HTB, NXCD = 8, WGM = 8;
__host__ __device__ __forceinline__ int lds_byte(int r, int c) { const int st = (r >> 4) * 2 + (c >> 5), rr = r & 15, cc = c & 31, ob = rr * 64 + cc * 2; return st * 1024 + (ob ^ (((ob >> 9) & 1) << 5)); }
__host__ __device__ __forceinline__ void stage_rc(int b, int& R, int& C) { const int st = b / 1024, sb = b % 1024, swz = sb ^ (((sb >> 9) & 1) << 5); R = (st >> 1) * 16 + swz / 64; C = (st & 1) * 32 + (swz % 64) / 2; }
__host__ __device__ __forceinline__ int perm32(int rho) { const int n = rho >> 4, i = rho & 15; return 8 * (i >> 2) + 4 * n + (i & 3); }

struct Unit { int pm, pn, z, kb, nt; };
struct Gemm { const bf16_t* A; const bf16_t* Bt; int lda, ldb, K; size_t zA, zB; };

template <int SEG> struct TileOrder {
    int nM, nN, nz, nwg, G, c, lat, nextra;
    __device__ __forceinline__ void init(int nM_, int nN_, int nz_, int G_, int c_, int lat_ = 0, int nextra_ = 0) { lat = lat_; nextra = nextra_; nM = lat ? 32 : nM_; nN = nN_; nz = nz_; nwg = nM * nN * nz; G = G_; c = c_; }
    __device__ __forceinline__ bool next(int i, Unit& u) const {
        const int ti = i / SEG, sg = i - ti * SEG;
        const long L = (long)ti * G + c; if (L >= nwg + nextra) return false;
        u.kb = 0; u.nt = 0;
        if (L >= nwg) { const int idx = (int)L - nwg, t = idx / 20, j = idx - t * 20; u.pm = t * 17; u.pn = j < 16 ? 8 + j : 24 + j; u.z = 0; return true; }
        int wgid = (int)L; { const int q = nwg / NXCD, r = nwg % NXCD, xcd = wgid % NXCD, off = wgid / NXCD; wgid = (xcd < r ? xcd * (q + 1) : r * (q + 1) + (xcd - r) * q) + off; }
        const int per = nM * nN, zz = wgid / per; wgid -= zz * per;
        const int nig = WGM * nN, gid = wgid / nig, fm = gid * WGM, gsz = (nM - fm) < WGM ? (nM - fm) : WGM;
        int pm = fm + ((wgid % nig) % gsz); if (lat) pm += 1 + (pm >= 16);
        u.pm = pm; u.pn = (wgid % nig) / gsz; u.z = (SEG > 1) ? sg : zz; return true;
    }
};

struct SplitOrder { int G, c, nta, ntb, nsub;
    __device__ __forceinline__ void init(int G_, int c_, int nta_, int ntb_, int nsub_) { G = G_; c = c_; nta = nta_; ntb = ntb_; nsub = nsub_; }
    __device__ __forceinline__ bool next(int i, Unit& u) const {
        const int L = i * G + c;
        const bool ok = L < 512 + nsub;
        const int w = (L & 7) * 64 + (L >> 3);
        const int gid = w >> 7, r = w & 127; int pm_l = gid * 8 + (r & 7); pm_l += 1 + (pm_l >= 16); const int pn_l = r >> 3;
        const int idx = L - 512, tile = idx >> 3, sp = idx & 7;
        const bool lat = L < 512;
        const int pm = lat ? pm_l : (tile >> 4) * 17, pn = lat ? pn_l : (tile & 15), z = lat ? 0 : sp;
        const int nt = lat ? 0 : (sp < 6 ? nta : ntb), kb = lat ? 0 : (sp < 6 ? sp * nta : 6 * nta + (sp - 6) * ntb) * BK;
        u.pm = pm; u.pn = pn; u.z = z; u.kb = kb; u.nt = nt;
        return ok;
    }
};

template <class Epi, class Sched, bool VARK = false, bool ALIGN_EPI = true, bool SP2 = true>
__device__ __forceinline__ void gemm_phase(LAS unsigned char* lds, const Gemm g, const Sched& S, const Epi& E) {
    int tid_ = threadIdx.x; asm volatile("" : "+v"(tid_));
    const int tid = tid_, wid = __builtin_amdgcn_readfirstlane(tid >> 6), lane = tid & 63, wr = wid >> 2, wc = wid & 3, fr = lane & 15, fq = lane >> 4;
    const int ntf = g.K / BK;
    unsigned voffA[2], voffB[2];
#pragma unroll
    for (int i = 0; i < 2; ++i) { int R, C; stage_rc(tid * 16 + i * 8192, R, C); const int Rb = Epi::PERM ? ((R & ~31) + perm32(R & 31)) : R;
        voffA[i] = (unsigned)(R * g.lda + C) * 2u; voffB[i] = (unsigned)(Rb * g.ldb + C) * 2u; }
    const size_t kstep = (size_t)(BK * 2);
    const size_t hstepA = (size_t)HALF * g.lda * 2, hstepB = (size_t)HALF * g.ldb * 2;
    const size_t tstepA = 2 * hstepA, tstepB = 2 * hstepB;
    const unsigned ldsw = (unsigned)wid * 1024u;
    const int aoff = lds_byte(wr * 64 + fr, fq * 8), boff = lds_byte(wc * 32 + fr, fq * 8);
#define PG8_SA(b, h) (((b) * 2 + (h)) * HTB)
#define PG8_SB(b, h) ((4 + (b) * 2 + (h)) * HTB)
#define PG8_STAGE(bufoff, gbase, voff) do { _Pragma("unroll") for (int _i = 0; _i < 2; ++_i) \
        __builtin_amdgcn_global_load_lds((const unsigned*)((const char*)(gbase) + (voff)[_i]), (LAS unsigned*)(lds + (bufoff) + ldsw + _i * 8192), 16, 0, 0); } while (0)
#define PG8_LDA(dst, b, h) do { _Pragma("unroll") for (int m = 0; m < 4; ++m) _Pragma("unroll") for (int k = 0; k < 2; ++k) dst[m][k] = *(const LAS bf16x8*)(lds + PG8_SA(b, h) + aoff + m * 2048 + k * 1024); } while (0)
#define PG8_LDB(dst, b, h) do { _Pragma("unroll") for (int n = 0; n < 2; ++n) _Pragma("unroll") for (int k = 0; k < 2; ++k) dst[n][k] = *(const LAS bf16x8*)(lds + PG8_SB(b, h) + boff + n * 2048 + k * 1024); } while (0)
#define PG8_MMA(ai, bj, At, Bt) do { __builtin_amdgcn_s_setprio(1); _Pragma("unroll") for (int m = 0; m < 4; ++m) _Pragma("unroll") for (int n = 0; n < 2; ++n) _Pragma("unroll") for (int k = 0; k < 2; ++k) \
        acc[ai][bj][m][n] = __builtin_amdgcn_mfma_f32_16x16x32_bf16(Bt[n][k], At[m][k], acc[ai][bj][m][n], 0, 0, 0); __builtin_amdgcn_s_setprio(0); } while (0)
#define PG8_WAIT_V(n) asm volatile("s_waitcnt vmcnt(" #n ")" ::: "memory")
#define PG8_WAIT_L(n) asm volatile("s_waitcnt lgkmcnt(" #n ")" ::: "memory")
#define PG8_BAR __builtin_amdgcn_s_barrier()
#define PG8_SCHED __builtin_amdgcn_sched_barrier(0)
    Unit cur{0, 0, 0, 0, 0}, nxt{0, 0, 0, 0, 0}; int ui = 0;
    if (!S.next(0, cur)) return;
    f32x4 acc[2][2][4][2];
#pragma unroll
    for (int a = 0; a < 2; ++a)
#pragma unroll
        for (int b = 0; b < 2; ++b)
#pragma unroll
            for (int m = 0; m < 4; ++m)
#pragma unroll
                for (int n = 0; n < 2; ++n) acc[a][b][m][n] = (f32x4){0.f, 0.f, 0.f, 0.f};
    bf16x8 At[4][2], B0[2][2], B1[2][2];
    const char* cA = (const char*)g.A + ((size_t)cur.z * g.zA + (VARK ? cur.kb : 0)) * 2 + (size_t)cur.pm * tstepA; const char* cB = (const char*)g.Bt + ((size_t)cur.z * g.zB + (VARK ? cur.kb : 0)) * 2 + (size_t)cur.pn * tstepB;
    if constexpr (SP2) {
        PG8_STAGE(PG8_SB(0, 0), cB, voffB); PG8_STAGE(PG8_SB(0, 1), cB + hstepB, voffB); PG8_STAGE(PG8_SA(0, 0), cA, voffA); PG8_STAGE(PG8_SA(0, 1), cA + hstepA, voffA);
        if (wr == 1) PG8_BAR;
        PG8_WAIT_V(2); PG8_BAR;
        PG8_STAGE(PG8_SB(1, 0), cB + kstep, voffB); PG8_STAGE(PG8_SA(1, 0), cA + kstep, voffA); PG8_STAGE(PG8_SB(1, 1), cB + hstepB + kstep, voffB);
        PG8_WAIT_V(6); PG8_BAR;
    } else {
        PG8_STAGE(PG8_SB(0, 0), cB, voffB); PG8_STAGE(PG8_SA(0, 0), cA, voffA); PG8_STAGE(PG8_SB(0, 1), cB + hstepB, voffB); PG8_STAGE(PG8_SA(0, 1), cA + hstepA, voffA);
        if (wr == 1) PG8_BAR;
        PG8_WAIT_V(4); PG8_BAR;
        PG8_STAGE(PG8_SB(1, 0), cB + kstep, voffB); PG8_STAGE(PG8_SA(1, 0), cA + kstep, voffA); PG8_STAGE(PG8_SB(1, 1), cB + hstepB + kstep, voffB);
        PG8_WAIT_V(6); PG8_BAR;
    }
#pragma unroll 1
    for (;;) {
        const bool has_next = S.next(ui + 1, nxt);
        const char* nA = has_next ? (const char*)g.A + ((size_t)nxt.z * g.zA + (VARK ? nxt.kb : 0)) * 2 + (size_t)nxt.pm * tstepA : cA;
        const char* nB = has_next ? (const char*)g.Bt + ((size_t)nxt.z * g.zB + (VARK ? nxt.kb : 0)) * 2 + (size_t)nxt.pn * tstepB : cB;
        const int nt = (VARK && cur.nt) ? cur.nt : ntf;
#pragma unroll 1
        for (int t = 0; t < nt; t += 2) {
            const bool last = (t == nt - 2);
            const char* a1 = cA + (size_t)(t + 1) * kstep;
            const char* a2 = last ? nA : cA + (size_t)(t + 2) * kstep; const char* b2 = last ? nB : cB + (size_t)(t + 2) * kstep;
            const char* a3 = a2 + kstep; const char* b3 = b2 + kstep;
            if constexpr (SP2) {
            PG8_LDB(B0, 0, 0); PG8_LDB(B1, 0, 1); PG8_SCHED; PG8_LDA(At, 0, 0); PG8_STAGE(PG8_SA(1, 1), a1 + hstepA, voffA);
            PG8_WAIT_V(8); PG8_WAIT_L(0); PG8_BAR; PG8_MMA(0, 0, At, B0); PG8_MMA(0, 1, At, B1); PG8_BAR; PG8_SCHED;
            PG8_LDA(At, 0, 1); PG8_STAGE(PG8_SB(0, 0), b2, voffB); PG8_STAGE(PG8_SB(0, 1), b2 + hstepB, voffB); PG8_STAGE(PG8_SA(0, 0), a2, voffA);
            PG8_WAIT_V(8); PG8_WAIT_L(0); PG8_BAR; PG8_MMA(1, 0, At, B0); PG8_MMA(1, 1, At, B1); PG8_BAR; PG8_SCHED;
            PG8_LDB(B0, 1, 0); PG8_LDB(B1, 1, 1); PG8_SCHED; PG8_LDA(At, 1, 0); PG8_STAGE(PG8_SA(0, 1), a2 + hstepA, voffA);
            PG8_WAIT_V(8); PG8_WAIT_L(0); PG8_BAR; PG8_MMA(0, 0, At, B0); PG8_MMA(0, 1, At, B1); PG8_BAR; PG8_SCHED;
            PG8_LDA(At, 1, 1); PG8_STAGE(PG8_SB(1, 0), b3, voffB); PG8_STAGE(PG8_SB(1, 1), b3 + hstepB, voffB); PG8_STAGE(PG8_SA(1, 0), a3, voffA);
            PG8_WAIT_V(8); PG8_WAIT_L(0); PG8_BAR; PG8_MMA(1, 0, At, B0); PG8_MMA(1, 1, At, B1); PG8_BAR; PG8_SCHED;
            } else {
            PG8_LDB(B0, 0, 0); PG8_SCHED; PG8_LDA(At, 0, 0); PG8_STAGE(PG8_SA(1, 1), a1 + hstepA, voffA);
            PG8_WAIT_L(8); PG8_BAR; PG8_WAIT_L(0); PG8_MMA(0, 0, At, B0); PG8_BAR; PG8_SCHED;
            PG8_LDB(B1, 0, 1); PG8_STAGE(PG8_SB(0, 0), b2, voffB);
            PG8_BAR; PG8_WAIT_L(0); PG8_MMA(0, 1, At, B1); PG8_BAR;
            PG8_LDA(At, 0, 1); PG8_STAGE(PG8_SA(0, 0), a2, voffA);
            PG8_BAR; PG8_WAIT_L(0); PG8_MMA(1, 0, At, B0); PG8_BAR; PG8_SCHED;
            PG8_STAGE(PG8_SB(0, 1), b2 + hstepB, voffB);
            PG8_WAIT_V(6); PG8_BAR; PG8_MMA(1, 1, At, B1); PG8_BAR;
            PG8_LDB(B0, 1, 0); PG8_SCHED; PG8_LDA(At, 1, 0); PG8_STAGE(PG8_SA(0, 1), a2 + hstepA, voffA);
            PG8_WAIT_L(8); PG8_BAR; PG8_WAIT_L(0); PG8_MMA(0, 0, At, B0); PG8_BAR; PG8_SCHED;
            PG8_LDB(B1, 1, 1); PG8_STAGE(PG8_SB(1, 0), b3, voffB);
            PG8_BAR; PG8_WAIT_L(0); PG8_MMA(0, 1, At, B1); PG8_BAR;
            PG8_LDA(At, 1, 1); PG8_STAGE(PG8_SA(1, 0), a3, voffA);
            PG8_BAR; PG8_WAIT_L(0); PG8_MMA(1, 0, At, B0); PG8_BAR; PG8_SCHED;
            PG8_STAGE(PG8_SB(1, 1), b3 + hstepB, voffB);
            PG8_WAIT_V(6); PG8_BAR; PG8_MMA(1, 1, At, B1); PG8_BAR;
            }
        }
        if constexpr (ALIGN_EPI) { if (wr == 0) PG8_BAR; }
        E(acc, cur, wr, wc, fr, fq);
        if (!has_next) break;
        if (!E.keep(cur)) {
#pragma unroll
        for (int a = 0; a < 2; ++a)
#pragma unroll
            for (int b = 0; b < 2; ++b)
#pragma unroll
                for (int m = 0; m < 4; ++m)
#pragma unroll
                    for (int n = 0; n < 2; ++n) acc[a][b][m][n] = (f32x4){0.f, 0.f, 0.f, 0.f};
        }
        cur.pm = nxt.pm; cur.pn = nxt.pn; cur.z = nxt.z; cur.kb = nxt.kb; cur.nt = nxt.nt; cA = nA; cB = nB; ++ui;
        if constexpr (ALIGN_EPI) { if (wr == 1) PG8_BAR; }
    }
    PG8_WAIT_V(0);
    if constexpr (!ALIGN_EPI) { if (wr == 0) PG8_BAR; }
    PG8_BAR;
#undef PG8_SA
#undef PG8_SB
#undef PG8_STAGE
#undef PG8_LDA
#undef PG8_LDB
#undef PG8_MMA
#undef PG8_WAIT_V
#undef PG8_WAIT_L
#undef PG8_BAR
#undef PG8_SCHED
}

typedef f32x4 Acc[2][2][4][2];

struct EpiBf16 {
    static constexpr bool PERM = true;
    bf16_t* O; int ldc; size_t zO; int row_off; const float* bias; int sig_pn0;
    __device__ __forceinline__ bool keep(const Unit&) const { return false; }
    __device__ __forceinline__ void operator()(Acc& acc, const Unit& u, int wr, int wc, int fr, int fq) const {
        const int row0 = row_off + u.pm * BM + wr * 64 + fr, col0 = u.pn * BM + wc * 32 + 8 * fq;
        bf16_t* base = O + (size_t)u.z * zO;
        const bool sig = u.pn >= sig_pn0;
        f32x4 bv[2][2];
#pragma unroll
        for (int bj = 0; bj < 2; ++bj)
#pragma unroll
            for (int n = 0; n < 2; ++n) bv[bj][n] = sig ? *(const f32x4*)(bias + (col0 - sig_pn0 * BM) + bj * HALF + 4 * n) : (f32x4){0.f, 0.f, 0.f, 0.f};
#pragma unroll
        for (int ai = 0; ai < 2; ++ai)
#pragma unroll
            for (int m = 0; m < 4; ++m) { bf16_t* rowp = base + (size_t)(row0 + ai * HALF + m * 16) * ldc + col0;
#pragma unroll
                for (int bj = 0; bj < 2; ++bj) { f32x4 v0 = acc[ai][bj][m][0], v1 = acc[ai][bj][m][1];
                    if (sig) { v0 += bv[bj][0]; v1 += bv[bj][1];
#pragma unroll
                        for (int j = 0; j < 4; ++j) { v0[j] = sigmoidf_(v0[j]); v1[j] = sigmoidf_(v1[j]); } }
                    u32x4 w; w.x = cvt_pk_bf16(v0[0], v0[1]); w.y = cvt_pk_bf16(v0[2], v0[3]); w.z = cvt_pk_bf16(v1[0], v1[1]); w.w = cvt_pk_bf16(v1[2], v1[3]);
                    *(u32x4*)(rowp + bj * HALF) = w; } }
    }
};
struct EpiF1 {
    static constexpr bool PERM = true;
    bf16_t* YT; bf16_t* YTC;
    __device__ __forceinline__ bool keep(const Unit&) const { return false; }
    __device__ __forceinline__ void operator()(Acc& acc, const Unit& u, int wr, int wc, int fr, int fq) const {
        const int b = u.pn / 17, pt = u.pn - b * 17;
        const int cp0 = wr * 64 + fr, tk0 = wc * 32 + 8 * fq;
        bf16_t* base; int ld;
        if (pt == 0) { base = YTC + ((size_t)(b * 8 + u.z) * 256) * 512 + u.pm * 256; ld = 512; }
        else { base = YT + ((size_t)(b * 8 + u.z) * 256) * 8192 + u.pm * 4096 + (pt - 1) * 256; ld = 8192; }
#pragma unroll
        for (int ai = 0; ai < 2; ++ai)
#pragma unroll
            for (int m = 0; m < 4; ++m) { bf16_t* rowp = base + (size_t)(cp0 + ai * HALF + m * 16) * ld + tk0;
#pragma unroll
                for (int bj = 0; bj < 2; ++bj) { const f32x4 v0 = acc[ai][bj][m][0], v1 = acc[ai][bj][m][1];
                    u32x4 w; w.x = cvt_pk_bf16(v0[0], v0[1]); w.y = cvt_pk_bf16(v0[2], v0[3]); w.z = cvt_pk_bf16(v1[0], v1[1]); w.w = cvt_pk_bf16(v1[2], v1[3]);
                    *(u32x4*)(rowp + bj * HALF) = w; } }
    }
};
struct EpiBranch {
    static constexpr bool PERM = true;
    const bf16_t* G; bf16_t* O;
    __device__ __forceinline__ bool keep(const Unit& u) const { return u.z < 2; }
    __device__ __forceinline__ void operator()(Acc& acc, const Unit& u, int wr, int wc, int fr, int fq) const {
        const int row0 = u.pm * BM + wr * 64 + fr, col0 = u.pn * BM + wc * 32 + 8 * fq;
#pragma unroll
        for (int ai = 0; ai < 2; ++ai)
#pragma unroll
            for (int m = 0; m < 4; ++m) { const size_t row = (size_t)(row0 + ai * HALF + m * 16);
#pragma unroll
                for (int bj = 0; bj < 2; ++bj) {
                    const u32x4 ga = *(const u32x4*)(G + row * N1 + u.z * DM + col0 + bj * HALF);
                    float s[8] = {bflo(ga.x), bfhi(ga.x), bflo(ga.y), bfhi(ga.y), bflo(ga.z), bfhi(ga.z), bflo(ga.w), bfhi(ga.w)};
                    if (u.z < 2) { const u32x4 gb = *(const u32x4*)(G + row * N1 + (u.z + 1) * DM + col0 + bj * HALF);
                        const float d[8] = {bflo(gb.x), bfhi(gb.x), bflo(gb.y), bfhi(gb.y), bflo(gb.z), bfhi(gb.z), bflo(gb.w), bfhi(gb.w)};
#pragma unroll
                        for (int j = 0; j < 8; ++j) s[j] = fmaxf(s[j], 1e-20f) * __builtin_amdgcn_rcpf(fmaxf(d[j], 1e-20f)); }
                    else {
#pragma unroll
                        for (int j = 0; j < 8; ++j) s[j] = fmaxf(s[j], 1e-20f); }
                    f32x4 v0 = acc[ai][bj][m][0], v1 = acc[ai][bj][m][1];
#pragma unroll
                    for (int j = 0; j < 4; ++j) { v0[j] *= s[j]; v1[j] *= s[4 + j]; }
                    acc[ai][bj][m][0] = v0; acc[ai][bj][m][1] = v1;
                    if (u.z == 2) { u32x4 w; w.x = cvt_pk_bf16(v0[0], v0[1]); w.y = cvt_pk_bf16(v0[2], v0[3]); w.z = cvt_pk_bf16(v1[0], v1[1]); w.w = cvt_pk_bf16(v1[2], v1[3]);
                        *(u32x4*)(O + row * DM + col0 + bj * HALF) = w; } } }
    }
};
struct EpiResid {
    static constexpr bool PERM = false;
    const float* X; float* Y; const float* gate; float* YP; const float* xin_l; const float* xin_c;
    __device__ __forceinline__ bool keep(const Unit&) const { return false; }
    __device__ __forceinline__ void operator()(Acc& acc, const Unit& u, int wr, int wc, int fr, int fq) const {
        const int row0 = u.pm * BM + wr * 64 + fr, col0 = u.pn * BM + wc * 32 + 4 * fq;
        if (u.nt) {
            float* yp = YP + ((size_t)u.z * 512 + (u.pm / 17) * 256 + wr * 64 + fr) * DM + col0;
#pragma unroll
            for (int ai = 0; ai < 2; ++ai)
#pragma unroll
                for (int m = 0; m < 4; ++m)
#pragma unroll
                    for (int bj = 0; bj < 2; ++bj)
#pragma unroll
                        for (int n = 0; n < 2; ++n) *(f32x4*)(yp + (size_t)(ai * HALF + m * 16) * DM + bj * HALF + n * 16) = acc[ai][bj][m][n];
            return; }
        const int b = u.pm / 17, pt = u.pm - b * 17, j = (pt == 0) ? 2 : b;
        const float* xb = xin_l ? (pt == 0 ? xin_c + (size_t)(b * CTX) * DM : xin_l + (size_t)(b * SEQ + (pt - 1) * 256) * DM) : X + (size_t)u.pm * BM * DM;
        const float* gv = gate + (size_t)j * NADA + col0;
        f32x4 gt[2][2];
#pragma unroll
        for (int bj = 0; bj < 2; ++bj)
#pragma unroll
            for (int n = 0; n < 2; ++n) gt[bj][n] = *(const f32x4*)(gv + bj * HALF + n * 16);
#pragma unroll
        for (int ai = 0; ai < 2; ++ai)
#pragma unroll
            for (int m = 0; m < 4; ++m) { const size_t off = (size_t)(row0 + ai * HALF + m * 16) * DM + col0, xoff = (size_t)(wr * 64 + fr + ai * HALF + m * 16) * DM + col0;
#pragma unroll
                for (int bj = 0; bj < 2; ++bj)
#pragma unroll
                    for (int n = 0; n < 2; ++n) { const f32x4 xv = *(const f32x4*)(xb + xoff + bj * HALF + n * 16);
                        *(f32x4*)(Y + off + bj * HALF + n * 16) = xv * DN_ALPHA + gt[bj][n] * acc[ai][bj][m][n]; }
                asm volatile("" ::: "memory"); }
    }
};
struct EpiProj {
    static constexpr bool PERM = true;
    bf16_t* O; const float* bias; const float* qkg; const float* rope; LAS float* EX; bf16_t* KV;
    __device__ __forceinline__ bool keep(const Unit&) const { return false; }
    __device__ __forceinline__ void operator()(Acc& acc, const Unit& u, int wr, int wc, int fr, int fq) const {
        const int row0 = u.pm * BM + wr * 64 + fr, col0 = u.pn * BM + wc * 32 + 8 * fq;
        const int pt = u.pm % 17; const bool lat = pt != 0;
        const int kind = (u.pn < 16) ? 1 : ((u.pn >= 32 && u.pn < 42) ? 2 : ((u.pn >= 44) ? 3 : 0));
        const int i0 = 16 * wc + 4 * fq;
        if (kind == 2) {
#pragma unroll
            for (int ai = 0; ai < 2; ++ai)
#pragma unroll
                for (int m = 0; m < 4; ++m)
#pragma unroll
                    for (int bj = 0; bj < 2; ++bj) { const f32x4 v0 = acc[ai][bj][m][0], v1 = acc[ai][bj][m][1];
                        float ss = (v0[0] * v0[0] + v0[1] * v0[1]) + (v0[2] * v0[2] + v0[3] * v0[3]) + (v1[0] * v1[0] + v1[1] * v1[1]) + (v1[2] * v1[2] + v1[3] * v1[3]);
                        ss += __shfl_xor(ss, 16); ss += __shfl_xor(ss, 32);
                        if (fq == 0) EX[((ai * HALF + wr * 64 + m * 16 + fr) * 2 + bj) * 4 + wc] = ss; }
            asm volatile("s_waitcnt lgkmcnt(0)" ::: "memory"); __builtin_amdgcn_s_barrier(); asm volatile("" ::: "memory");
            const float* gg = qkg + (u.pn >= 40 ? 128 : 0);
            const f32x4 gA = *(const f32x4*)(gg + i0), gB = *(const f32x4*)(gg + 64 + i0);
#pragma unroll
            for (int ai = 0; ai < 2; ++ai)
#pragma unroll
                for (int m = 0; m < 4; ++m)
#pragma unroll
                    for (int bj = 0; bj < 2; ++bj) { const f32x4 p = *(const LAS f32x4*)(EX + ((ai * HALF + wr * 64 + m * 16 + fr) * 2 + bj) * 4);
                        const float r = 1.0f / sqrtf(((p[0] + p[1]) + (p[2] + p[3])) * (1.0f / 128.0f) + NORM_EPS);
                        f32x4 v0 = acc[ai][bj][m][0], v1 = acc[ai][bj][m][1];
                        v0[0] *= r * gA[0]; v0[1] *= r * gB[0]; v0[2] *= r * gA[1]; v0[3] *= r * gB[1];
                        v1[0] *= r * gA[2]; v1[1] *= r * gB[2]; v1[2] *= r * gA[3]; v1[3] *= r * gB[3];
                        acc[ai][bj][m][0] = v0; acc[ai][bj][m][1] = v1; }
        }
        const bool sig = kind == 3;
        f32x4 bv[2][2];
#pragma unroll
        for (int bj = 0; bj < 2; ++bj)
#pragma unroll
            for (int n = 0; n < 2; ++n) bv[bj][n] = sig ? *(const f32x4*)(bias + (col0 - DIN) + bj * HALF + 4 * n) : (f32x4){0.f, 0.f, 0.f, 0.f};
        const bool dorope = lat && (kind == 1 || kind == 2);
        const int t0 = (pt - 1) * 256 + wr * 64 + fr;
        const bool iskv = (u.pn >= 8 && u.pn < 24) || (u.pn >= 40 && u.pn < 44);
        const int slot0 = (u.pn < 24) ? (u.pn - 8) * 2 : 32 + (u.pn - 40) * 2;
        bf16_t* kvb = KV + (((size_t)((u.pm / 17) * 40 + slot0)) * LT + pt * 256 + wr * 64 + fr) * 128 + wc * 32 + 8 * fq;
#pragma unroll
        for (int ai = 0; ai < 2; ++ai)
#pragma unroll
            for (int m = 0; m < 4; ++m) { bf16_t* rowp = O + (size_t)(row0 + ai * HALF + m * 16) * N1 + col0;
                f32x4 cs0 = {1.f, 0.f, 1.f, 0.f}, cs1 = cs0;
                if (dorope) { const float* rp = rope + ((size_t)(t0 + ai * HALF + m * 16) * 64 + i0) * 2; cs0 = *(const f32x4*)rp; cs1 = *(const f32x4*)(rp + 4); }
#pragma unroll
                for (int bj = 0; bj < 2; ++bj) { f32x4 v0 = acc[ai][bj][m][0], v1 = acc[ai][bj][m][1];
                    if (sig) { v0 += bv[bj][0]; v1 += bv[bj][1];
#pragma unroll
                        for (int j = 0; j < 4; ++j) { v0[j] = sigmoidf_(v0[j]); v1[j] = sigmoidf_(v1[j]); } }
                    if (dorope) {
                        const f32x4 a = v0, b = v1;
                        v0[0] = a[0] * cs0[0] - a[1] * cs0[1]; v0[1] = a[1] * cs0[0] + a[0] * cs0[1]; v0[2] = a[2] * cs0[2] - a[3] * cs0[3]; v0[3] = a[3] * cs0[2] + a[2] * cs0[3];
                        v1[0] = b[0] * cs1[0] - b[1] * cs1[1]; v1[1] = b[1] * cs1[0] + b[0] * cs1[1]; v1[2] = b[2] * cs1[2] - b[3] * cs1[3]; v1[3] = b[3] * cs1[2] + b[2] * cs1[3]; }
                    u32x4 w; w.x = cvt_pk_bf16(v0[0], v0[1]); w.y = cvt_pk_bf16(v0[2], v0[3]); w.z = cvt_pk_bf16(v1[0], v1[1]); w.w = cvt_pk_bf16(v1[2], v1[3]);
                    if (iskv) *(u32x4*)(kvb + (size_t)bj * LT * 128 + (size_t)(ai * HALF + m * 16) * 128) = w;
                    else *(u32x4*)(rowp + bj * HALF) = w; } }
    }
};
struct EpiConv {
    static constexpr bool PERM = true;
    bf16_t* U2; const float* cw; const float* cb; float* AE; float* CP; float* GP; LAS float* EX;
    __device__ __forceinline__ bool keep(const Unit&) const { return false; }
    __device__ __forceinline__ void operator()(Acc& acc, const Unit& u, int wr, int wc, int fr, int fq) const {
        const int lane = fr + 16 * fq;
#pragma unroll
        for (int ai = 0; ai < 2; ++ai) { const int q = 2 * ai + wr;
            if (fr == 0) { *(LAS f32x4*)(EX + ((q * 2 + 0) * 4 + wc) * 32 + 8 * fq) = acc[ai][0][0][0]; *(LAS f32x4*)(EX + ((q * 2 + 0) * 4 + wc) * 32 + 8 * fq + 4) = acc[ai][0][0][1]; }
            if (fr == 15) { *(LAS f32x4*)(EX + ((q * 2 + 1) * 4 + wc) * 32 + 8 * fq) = acc[ai][0][3][0]; *(LAS f32x4*)(EX + ((q * 2 + 1) * 4 + wc) * 32 + 8 * fq + 4) = acc[ai][0][3][1]; } }
        asm volatile("s_waitcnt lgkmcnt(0)" ::: "memory"); __builtin_amdgcn_s_barrier(); asm volatile("" ::: "memory");
        const int f0 = u.pn * 128 + wc * 32 + 8 * fq;
        const int row0 = u.pm * BM + wr * 64 + fr;
#pragma unroll
        for (int n = 0; n < 2; ++n) {
            const f32x4 w0 = *(const f32x4*)(cw + f0 + 4 * n), w1 = *(const f32x4*)(cw + DFF + f0 + 4 * n), w2 = *(const f32x4*)(cw + 2 * DFF + f0 + 4 * n), bv = *(const f32x4*)(cb + f0 + 4 * n);
#pragma unroll
            for (int ai = 0; ai < 2; ++ai) { const int q = 2 * ai + wr;
                f32x4 hup = {0.f, 0.f, 0.f, 0.f}, hdn = hup;
                if (q > 0) hup = *(const LAS f32x4*)(EX + (((q - 1) * 2 + 1) * 4 + wc) * 32 + 8 * fq + 4 * n);
                if (q < 3) hdn = *(const LAS f32x4*)(EX + (((q + 1) * 2 + 0) * 4 + wc) * 32 + 8 * fq + 4 * n);
#pragma unroll
                for (int m = 0; m < 4; ++m) {
                    const f32x4 a = acc[ai][0][m][n], g = acc[ai][1][m][n];
                    f32x4 c;
#pragma unroll
                    for (int j = 0; j < 4; ++j) {
                        const float t1 = __shfl(a[j], lane - 1), t2 = (m > 0) ? __shfl(acc[ai][0][m > 0 ? m - 1 : 0][n][j], lane + 15) : hup[j];
                        const float d1 = __shfl(a[j], lane + 1), d2 = (m < 3) ? __shfl(acc[ai][0][m < 3 ? m + 1 : 3][n][j], lane - 15) : hdn[j];
                        const float up = (fr == 0) ? t2 : t1, dn = (fr == 15) ? d2 : d1;
                        c[j] = w0[j] * up + w1[j] * a[j] + w2[j] * dn + bv[j]; }
                    const f32x2 g0 = gelu_pk((f32x2){c[0], c[1]}), g1 = gelu_pk((f32x2){c[2], c[3]});
                    u32x2 w; w.x = cvt_pk_bf16(g0.x * g[0], g0.y * g[1]); w.y = cvt_pk_bf16(g1.x * g[2], g1.y * g[3]);
                    *(u32x2*)(U2 + (size_t)(row0 + ai * HALF + m * 16) * DFF + f0 + 4 * n) = w;
                    if ((q == 0 && m == 0 && fr == 0) || (q == 3 && m == 3 && fr == 15)) { const size_t eo = ((size_t)(u.pm * 2 + (q == 3 ? 1 : 0))) * DFF + f0 + 4 * n;
                        *(f32x4*)(AE + eo) = a; *(f32x4*)(CP + eo) = c; *(f32x4*)(GP + eo) = g; }
                }
            }
        }
    }
};
struct OrdZ { int G, c, n, shift;
    __device__ __forceinline__ bool next(int i, Unit& u) const { u.kb = 0; u.nt = 0; const int L = i * G + c; if (L >= n) return false; const int q = n / 8, xcd = L % 8, off = L / 8, w = xcd * q + off; u.z = w >> shift; u.pm = w & ((1 << shift) - 1); u.pn = 0; return true; } };
struct EpiF2 {
    static constexpr bool PERM = true;
    bf16_t* O; int roff;
    __device__ __forceinline__ bool keep(const Unit&) const { return false; }
    __device__ __forceinline__ void operator()(Acc& acc, const Unit& u, int wr, int wc, int fr, int fq) const {
        const int b = u.z >> 3, gq = u.z & 7;
        bf16_t* base = O + (size_t)(b * LT + roff + u.pm * 256 + wr * 64 + fr) * BW + gq * 256 + wc * 32 + 8 * fq;
#pragma unroll
        for (int ai = 0; ai < 2; ++ai)
#pragma unroll
            for (int m = 0; m < 4; ++m)
#pragma unroll
                for (int bj = 0; bj < 2; ++bj) { const f32x4 v0 = acc[ai][bj][m][0], v1 = acc[ai][bj][m][1];
                    u32x4 w; w.x = cvt_pk_bf16(v0[0], v0[1]); w.y = cvt_pk_bf16(v0[2], v0[3]); w.z = cvt_pk_bf16(v1[0], v1[1]); w.w = cvt_pk_bf16(v1[2], v1[3]);
                    *(u32x4*)(base + (size_t)(ai * 128 + m * 16) * BW + bj * 128) = w; }
    }
};
}

namespace att {
constexpr int D = 128, NW = 8, QBLK = 32, KVBLK = 64;
constexpr float SCALE = 0.088388347648318440f;
constexpr float THR = 8.f;
constexpr int LDQ = N1, LDK = 128, LDO = BW;
constexpr size_t SHM_V = KVBLK * D * 2, SHM_K = KVBLK * D * 2, SHM_ATTN = 2 * SHM_V + 2 * SHM_K + NW * 64 * 4;
#define KSWZ(row, colB) ((row) * 256 + ((colB) ^ (((row) & 7) << 4)))
#define SBAR() __builtin_amdgcn_sched_barrier(0)
__device__ __forceinline__ int crow(int r, int hi) { return (r & 3) + 8 * (r >> 2) + 4 * hi; }
__device__ __forceinline__ unsigned cvtpk(float lo, float hi) { unsigned r; asm volatile("v_cvt_pk_bf16_f32 %0, %1, %2" : "=v"(r) : "v"(lo), "v"(hi)); return r; }
__device__ __forceinline__ void partialSM(f32x16& p0, f32x16& p1, float& m_reg, float& mn, float& alpha) {
  constexpr float C = SCALE * 1.4426950408889634f;
  float pmax = p0[0];
#pragma unroll
  for (int r = 1; r < 16; ++r) pmax = fmaxf(pmax, p0[r]);
#pragma unroll
  for (int r = 0; r < 16; ++r) pmax = fmaxf(pmax, p1[r]);
  { auto rr = __builtin_amdgcn_permlane32_swap(__float_as_uint(pmax), __float_as_uint(pmax), false, false);
    pmax = fmaxf(__uint_as_float(rr[0]), __uint_as_float(rr[1])); }
  if (__builtin_expect(__all(pmax - m_reg <= THR / SCALE), 1)) { mn = m_reg; alpha = 1.f; }
  else { mn = fmaxf(m_reg, pmax); alpha = __builtin_amdgcn_exp2f((m_reg - mn) * C); m_reg = mn; }
  float mnC = -mn * C;
#pragma unroll
  for (int r = 0; r < 16; ++r) p0[r] = fmaf(p0[r], C, mnC);
#pragma unroll
  for (int r = 0; r < 16; ++r) p1[r] = fmaf(p1[r], C, mnC);
#pragma unroll
  for (int r = 0; r < 16; ++r) p0[r] = __builtin_amdgcn_exp2f(p0[r]);
}
__device__ __forceinline__ void finishSM(f32x16& p0, f32x16& p1, float alpha, float& l_reg, bf16x8& pa0, bf16x8& pa1, bf16x8& pa2, bf16x8& pa3) {
#pragma unroll
  for (int r = 0; r < 16; ++r) p1[r] = __builtin_amdgcn_exp2f(p1[r]);
  float ps = 0;
#pragma unroll
  for (int r = 0; r < 16; ++r) ps += p0[r];
#pragma unroll
  for (int r = 0; r < 16; ++r) ps += p1[r];
  { auto rr = __builtin_amdgcn_permlane32_swap(__float_as_uint(ps), __float_as_uint(ps), false, false);
    ps = __uint_as_float(rr[0]) + __uint_as_float(rr[1]); }
  l_reg = l_reg * alpha + ps;
#define PK4(P, BASE, OUT) do { unsigned a0 = cvtpk(P[BASE + 0], P[BASE + 1]), a1 = cvtpk(P[BASE + 2], P[BASE + 3]);   \
    unsigned b0 = cvtpk(P[BASE + 4], P[BASE + 5]), b1 = cvtpk(P[BASE + 6], P[BASE + 7]);                              \
    auto r0 = __builtin_amdgcn_permlane32_swap(a0, b0, false, false); auto r1 = __builtin_amdgcn_permlane32_swap(a1, b1, false, false); \
    u32x4 w = {r0[0], r1[0], r0[1], r1[1]}; OUT = *reinterpret_cast<bf16x8*>(&w); } while (0)
  PK4(p0, 0, pa0); PK4(p0, 8, pa1); PK4(p1, 0, pa2); PK4(p1, 8, pa3);
#undef PK4
}
__device__ __forceinline__ void qkt(f32x16& p0, f32x16& p1, const bf16_t* Ks, const bf16x8* qr, int r32, int hi) {
  p0 = f32x16{}; p1 = f32x16{};
#pragma unroll
  for (int d0 = 0; d0 < 8; ++d0) { int cb = (d0 * 16 + hi * 8) * 2;
    bf16x8 b0 = *reinterpret_cast<const bf16x8*>((const char*)Ks + KSWZ(r32, cb));
    bf16x8 b1 = *reinterpret_cast<const bf16x8*>((const char*)Ks + KSWZ(32 + r32, cb));
    p0 = __builtin_amdgcn_mfma_f32_32x32x16_bf16(b0, qr[d0], p0, 0, 0, 0);
    p1 = __builtin_amdgcn_mfma_f32_32x32x16_bf16(b1, qr[d0], p1, 0, 0, 0); }
}
__device__ __forceinline__ int v_st(int k, int c) { const int kk = (k & ~0xC) | ((k & 4) << 1) | ((k & 8) >> 1); return ((kk >> 3) * 4 + (c >> 5)) * 512 + ((kk & 7) * 32 + (c & 31)) * 2; }
__device__ __forceinline__ int v_rd_base(int lane) { return ((lane & 3) << 3) | (((lane >> 2) & 3) << 6) | (((lane >> 4) & 1) << 5) | (((lane >> 5) & 1) << 8); }
constexpr int v_rd_off(int d0, int ks, int half) { return d0 * 512 + ks * 4096 + half * 2048; }
template <int OFF> __device__ __forceinline__ s16x4 tr_read(int vb) {
  s16x4 r; asm volatile("ds_read_b64_tr_b16 %0, %1 offset:%2" : "=&v"(r) : "v"(vb), "i"(OFF) : "memory"); return r;
}
template <int D0> __device__ __forceinline__ void pv_one(f32x16& od, int vb, bf16x8 pa0, bf16x8 pa1, bf16x8 pa2, bf16x8 pa3) {
  const s16x4 l0 = tr_read<v_rd_off(D0, 0, 0)>(vb), h0 = tr_read<v_rd_off(D0, 0, 1)>(vb), l1 = tr_read<v_rd_off(D0, 1, 0)>(vb), h1 = tr_read<v_rd_off(D0, 1, 1)>(vb);
  const s16x4 l2 = tr_read<v_rd_off(D0, 2, 0)>(vb), h2 = tr_read<v_rd_off(D0, 2, 1)>(vb), l3 = tr_read<v_rd_off(D0, 3, 0)>(vb), h3 = tr_read<v_rd_off(D0, 3, 1)>(vb);
  asm volatile("s_waitcnt lgkmcnt(0)" ::: "memory"); SBAR();
#define PK(L, H) (bf16x8){L[0], L[1], L[2], L[3], H[0], H[1], H[2], H[3]}
  od = __builtin_amdgcn_mfma_f32_32x32x16_bf16(pa0, PK(l0, h0), od, 0, 0, 0);
  od = __builtin_amdgcn_mfma_f32_32x32x16_bf16(pa1, PK(l1, h1), od, 0, 0, 0);
  od = __builtin_amdgcn_mfma_f32_32x32x16_bf16(pa2, PK(l2, h2), od, 0, 0, 0);
  od = __builtin_amdgcn_mfma_f32_32x32x16_bf16(pa3, PK(l3, h3), od, 0, 0, 0);
#undef PK
}
__device__ __forceinline__ void pv_d0(f32x16* o, int vb, bf16x8 pa0, bf16x8 pa1, bf16x8 pa2, bf16x8 pa3) {
  pv_one<0>(o[0], vb, pa0, pa1, pa2, pa3); pv_one<1>(o[1], vb, pa0, pa1, pa2, pa3); pv_one<2>(o[2], vb, pa0, pa1, pa2, pa3); pv_one<3>(o[3], vb, pa0, pa1, pa2, pa3);
}
__device__ __forceinline__ void attn_dense_body(const bf16_t* __restrict__ Qb, const bf16_t* __restrict__ Kh, const bf16_t* __restrict__ Vh, void* __restrict__ Obv, int OBF, int seq, char* lds) {
  int tid_ = threadIdx.x; asm volatile("" : "+v"(tid_));
  const int tid = tid_, wid = tid >> 6, lane = tid & 63, r32 = lane & 31, hi = lane >> 5;
  bf16_t* V_lds = (bf16_t*)lds; bf16_t* K_lds = (bf16_t*)(lds + 2 * SHM_V);
  float* ws = (float*)(lds + 2 * SHM_V + 2 * SHM_K) + wid * 64; float* li_l = ws; float* al_l = ws + 32;
  float m_reg = -1e30f, l_reg = 0; f32x16 o[4] = {}; bf16x8 qr[8];
  const bf16_t* Qw = Qb + (long)(wid * QBLK + r32) * LDQ + hi * 8;
#pragma unroll
  for (int d0 = 0; d0 < 8; ++d0) qr[d0] = *reinterpret_cast<const bf16x8*>(Qw + d0 * 16);
  const int sr = tid >> 4, sc = (tid & 15) * 8, vst0 = v_st(sr, sc), vst1 = v_st(32 + sr, sc);
  const int vb0 = (int)(uintptr_t)V_lds + v_rd_base(lane);
  struct { bf16x8 vs0, vs1, ks0, ks1; } sr_[2];
#define SLOAD(i, k0) do { sr_[i].vs0 = *reinterpret_cast<const bf16x8*>(&Vh[(long)((k0) + sr) * LDK + sc]); sr_[i].vs1 = *reinterpret_cast<const bf16x8*>(&Vh[(long)((k0) + 32 + sr) * LDK + sc]); \
    sr_[i].ks0 = *reinterpret_cast<const bf16x8*>(&Kh[(long)((k0) + sr) * LDK + sc]); sr_[i].ks1 = *reinterpret_cast<const bf16x8*>(&Kh[(long)((k0) + 32 + sr) * LDK + sc]); } while (0)
#define SWRITE(b, i) do { *(bf16x8*)((char*)V_lds + (b) * SHM_V + vst0) = sr_[i].vs0;          \
    *(bf16x8*)((char*)V_lds + (b) * SHM_V + vst1) = sr_[i].vs1; int kc = sc * 2;               \
    *(bf16x8*)((char*)K_lds + (b) * SHM_K + KSWZ(sr, kc)) = sr_[i].ks0;                       \
    *(bf16x8*)((char*)K_lds + (b) * SHM_K + KSWZ(32 + sr, kc)) = sr_[i].ks1; } while (0)
#define SWAIT() asm volatile("s_waitcnt vmcnt(4)" ::: "memory")
#define RESC(a) do { if (__any((a) < 1.f)) { if (hi == 0) al_l[r32] = (a); asm volatile("s_waitcnt lgkmcnt(0)" ::: "memory"); \
    _Pragma("unroll") for (int d = 0; d < 4; ++d) _Pragma("unroll") for (int r = 0; r < 16; ++r) o[d][r] *= al_l[crow(r, hi)]; } } while (0)
  f32x16 pA0, pA1, pB0, pB1; float mnA, mnB, alA, alB; bf16x8 pa0, pa1, pa2, pa3; const int NT = seq / KVBLK;
  constexpr int SE = 0, SO = 1;
  SLOAD(SE, 0); asm volatile("s_waitcnt vmcnt(0)" ::: "memory"); SWRITE(0, SE); __syncthreads();
  qkt(pA0, pA1, K_lds, qr, r32, hi); partialSM(pA0, pA1, m_reg, mnA, alA);
  SLOAD(SO, KVBLK); if (2 < NT) SLOAD(SE, 2 * KVBLK);
  SWAIT(); SWRITE(1, SO); __syncthreads();
  for (int j = 1; j + 1 < NT; j += 2) {
    SBAR(); qkt(pB0, pB1, (bf16_t*)((char*)K_lds + SHM_K), qr, r32, hi);
    finishSM(pA0, pA1, alA, l_reg, pa0, pa1, pa2, pa3); SBAR();
    SLOAD(SO, (j + 2) * KVBLK); SBAR();
    pv_d0(o, vb0, pa0, pa1, pa2, pa3); partialSM(pB0, pB1, m_reg, mnB, alB);
    __syncthreads(); SWAIT(); SWRITE(0, SE);
    RESC(alB); __syncthreads();
    SBAR(); qkt(pA0, pA1, K_lds, qr, r32, hi);
    finishSM(pB0, pB1, alB, l_reg, pa0, pa1, pa2, pa3); SBAR();
    if (j + 3 < NT) SLOAD(SE, (j + 3) * KVBLK); SBAR();
    pv_d0(o, vb0 + (int)SHM_V, pa0, pa1, pa2, pa3); partialSM(pA0, pA1, m_reg, mnA, alA);
    __syncthreads(); SWAIT(); SWRITE(1, SO);
    RESC(alA); __syncthreads();
  }
  SBAR(); qkt(pB0, pB1, (bf16_t*)((char*)K_lds + SHM_K), qr, r32, hi);
  finishSM(pA0, pA1, alA, l_reg, pa0, pa1, pa2, pa3); SBAR();
  pv_d0(o, vb0, pa0, pa1, pa2, pa3); partialSM(pB0, pB1, m_reg, mnB, alB);
  __syncthreads(); RESC(alB);
  finishSM(pB0, pB1, alB, l_reg, pa0, pa1, pa2, pa3); SBAR();
  pv_d0(o, vb0 + (int)SHM_V, pa0, pa1, pa2, pa3);
  if (hi == 0) li_l[r32] = l_reg; asm volatile("s_waitcnt lgkmcnt(0)" ::: "memory");
  float rli[16];
#pragma unroll
  for (int r = 0; r < 16; ++r) rli[r] = __builtin_amdgcn_rcpf(li_l[crow(r, hi)]);
  if (OBF) {
    bf16_t* Ow = (bf16_t*)Obv + (long)(wid * QBLK) * LDO;
#pragma unroll
    for (int r = 0; r < 16; ++r) { int orow = crow(r, hi);
#pragma unroll
      for (int d0 = 0; d0 < 4; ++d0) Ow[(long)orow * LDO + d0 * 32 + r32] = (bf16_t)f2bf(o[d0][r] * rli[r]); }
  } else {
    float* Ow = (float*)Obv + (long)(wid * QBLK) * LDO;
#pragma unroll
    for (int r = 0; r < 16; ++r) { int orow = crow(r, hi);
#pragma unroll
      for (int d0 = 0; d0 < 4; ++d0) Ow[(long)orow * LDO + d0 * 32 + r32] = o[d0][r] * rli[r]; }
  }
#undef SLOAD
#undef SWRITE
#undef SWAIT
#undef RESC
}

__device__ __forceinline__ void attn_diff_body(const bf16_t* __restrict__ Qb, const bf16_t* __restrict__ Kh, const bf16_t* __restrict__ Vlo, const bf16_t* __restrict__ Vhi,
                                               float* __restrict__ Olo, float* __restrict__ Ohi, int seq, char* lds, char* lx) {
  int tid_ = threadIdx.x; asm volatile("" : "+v"(tid_));
  const int tid = tid_, wid = tid >> 6, lane = tid & 63, r32 = lane & 31, hi = lane >> 5, pw = wid & 3;
  char* VL = lds; char* VH = lds + 2 * SHM_V; char* KL = lds + 4 * SHM_V; char* PB = lds + 4 * SHM_V + 2 * SHM_K;
  float* AL = (float*)lx; float* LI = (float*)lx + 512;
  const int NT = seq / KVBLK;
  const int t2 = tid & 255, sr = t2 >> 4, sc = (t2 & 15) * 8;
  bf16x8 pa0, pa1, pa2, pa3;
  float* alw = AL + pw * 32;
#define RESCX(t) do { const float* al_ = alw + ((t) & 3) * 128; const float a_ = al_[r32]; if (__any(a_ < 1.f)) { \
    _Pragma("unroll") for (int d = 0; d < 8; ++d) _Pragma("unroll") for (int r = 0; r < 16; ++r) o[d][r] *= al_[crow(r, hi)]; } } while (0)
  if (wid < 4) {
    float m_reg = -1e30f, l_reg = 0; bf16x8 qr[8];
    const bf16_t* Qw = Qb + (long)(pw * QBLK + r32) * LDQ + hi * 8;
#pragma unroll
    for (int d0 = 0; d0 < 8; ++d0) qr[d0] = *reinterpret_cast<const bf16x8*>(Qw + d0 * 16);
    bf16x8 ka0, ka1, ka2, ka3;
#define KLOAD(S, k0) do { S##0 = *reinterpret_cast<const bf16x8*>(&Kh[(long)((k0) + sr) * LDK + sc]); S##1 = *reinterpret_cast<const bf16x8*>(&Kh[(long)((k0) + 16 + sr) * LDK + sc]); \
    S##2 = *reinterpret_cast<const bf16x8*>(&Kh[(long)((k0) + 32 + sr) * LDK + sc]); S##3 = *reinterpret_cast<const bf16x8*>(&Kh[(long)((k0) + 48 + sr) * LDK + sc]); } while (0)
#define KWRITE(b, S) do { const int kc = sc * 2; *(bf16x8*)(KL + (b) * SHM_K + KSWZ(sr, kc)) = S##0; *(bf16x8*)(KL + (b) * SHM_K + KSWZ(16 + sr, kc)) = S##1; \
    *(bf16x8*)(KL + (b) * SHM_K + KSWZ(32 + sr, kc)) = S##2; *(bf16x8*)(KL + (b) * SHM_K + KSWZ(48 + sr, kc)) = S##3; } while (0)
#define PWRITE(par) do { char* p_ = PB + (par) * 16384 + pw * 4096 + lane * 64; *(bf16x8*)p_ = pa0; *(bf16x8*)(p_ + 16) = pa1; *(bf16x8*)(p_ + 32) = pa2; *(bf16x8*)(p_ + 48) = pa3; } while (0)
#define AWRITE(t, a) do { if (hi == 0) alw[((t) & 3) * 128 + r32] = (a); } while (0)
    f32x16 pA0, pA1, pB0, pB1; float mnA, mnB, alA, alB;
    KLOAD(ka, 0); asm volatile("s_waitcnt vmcnt(0)" ::: "memory"); KWRITE(0, ka); __syncthreads();
    qkt(pA0, pA1, (const bf16_t*)KL, qr, r32, hi); partialSM(pA0, pA1, m_reg, mnA, alA); AWRITE(0, alA);
    KLOAD(ka, KVBLK);
    asm volatile("s_waitcnt vmcnt(0)" ::: "memory"); KWRITE(1, ka); __syncthreads();
    for (int j = 1; j + 1 < NT; j += 2) {
      KLOAD(ka, (j + 1) * KVBLK);
      SBAR(); qkt(pB0, pB1, (const bf16_t*)(KL + SHM_K), qr, r32, hi);
      finishSM(pA0, pA1, alA, l_reg, pa0, pa1, pa2, pa3); SBAR();
      PWRITE(0);
      partialSM(pB0, pB1, m_reg, mnB, alB); AWRITE(j, alB);
      __syncthreads();
      KWRITE(0, ka);
      __syncthreads();
      KLOAD(ka, (j + 2) * KVBLK);
      SBAR(); qkt(pA0, pA1, (const bf16_t*)KL, qr, r32, hi);
      finishSM(pB0, pB1, alB, l_reg, pa0, pa1, pa2, pa3); SBAR();
      PWRITE(1);
      partialSM(pA0, pA1, m_reg, mnA, alA); AWRITE(j + 1, alA);
      __syncthreads();
      KWRITE(1, ka);
      __syncthreads();
    }
    SBAR(); qkt(pB0, pB1, (const bf16_t*)(KL + SHM_K), qr, r32, hi);
    finishSM(pA0, pA1, alA, l_reg, pa0, pa1, pa2, pa3); SBAR();
    PWRITE(0);
    partialSM(pB0, pB1, m_reg, mnB, alB); AWRITE(NT - 1, alB);
    __syncthreads();
    __syncthreads();
    finishSM(pB0, pB1, alB, l_reg, pa0, pa1, pa2, pa3); SBAR();
    PWRITE(1);
    if (hi == 0) LI[pw * 32 + r32] = l_reg;
    __syncthreads();
    asm volatile("s_waitcnt vmcnt(0)" ::: "memory"); __syncthreads();
#undef KLOAD
#undef KWRITE
#undef PWRITE
#undef AWRITE
  } else {
    const int vbL = (int)(uintptr_t)VL + v_rd_base(lane), vbH = (int)(uintptr_t)VH + v_rd_base(lane);
    f32x16 o[8] = {};
    bf16x8 la0, la1, la2, la3, ha0, ha1, ha2, ha3, lb0, lb1, lb2, lb3, hb0, hb1, hb2, hb3;
#define VLOAD(S, k0) do { l##S##0 = *reinterpret_cast<const bf16x8*>(&Vlo[(long)((k0) + sr) * LDK + sc]); l##S##1 = *reinterpret_cast<const bf16x8*>(&Vlo[(long)((k0) + 16 + sr) * LDK + sc]); \
    l##S##2 = *reinterpret_cast<const bf16x8*>(&Vlo[(long)((k0) + 32 + sr) * LDK + sc]); l##S##3 = *reinterpret_cast<const bf16x8*>(&Vlo[(long)((k0) + 48 + sr) * LDK + sc]); \
    h##S##0 = *reinterpret_cast<const bf16x8*>(&Vhi[(long)((k0) + sr) * LDK + sc]); h##S##1 = *reinterpret_cast<const bf16x8*>(&Vhi[(long)((k0) + 16 + sr) * LDK + sc]); \
    h##S##2 = *reinterpret_cast<const bf16x8*>(&Vhi[(long)((k0) + 32 + sr) * LDK + sc]); h##S##3 = *reinterpret_cast<const bf16x8*>(&Vhi[(long)((k0) + 48 + sr) * LDK + sc]); } while (0)
#define VWRITE(b, S) do { *(bf16x8*)(VL + (b) * SHM_V + v_st(sr, sc)) = l##S##0; *(bf16x8*)(VL + (b) * SHM_V + v_st(16 + sr, sc)) = l##S##1; \
    *(bf16x8*)(VL + (b) * SHM_V + v_st(32 + sr, sc)) = l##S##2; *(bf16x8*)(VL + (b) * SHM_V + v_st(48 + sr, sc)) = l##S##3; \
    *(bf16x8*)(VH + (b) * SHM_V + v_st(sr, sc)) = h##S##0; *(bf16x8*)(VH + (b) * SHM_V + v_st(16 + sr, sc)) = h##S##1; \
    *(bf16x8*)(VH + (b) * SHM_V + v_st(32 + sr, sc)) = h##S##2; *(bf16x8*)(VH + (b) * SHM_V + v_st(48 + sr, sc)) = h##S##3; } while (0)
#define XSTEP(t) do { const char* p_ = PB + ((t) & 1) * 16384 + pw * 4096 + lane * 64; pa0 = *(const bf16x8*)p_; pa1 = *(const bf16x8*)(p_ + 16); pa2 = *(const bf16x8*)(p_ + 32); pa3 = *(const bf16x8*)(p_ + 48); \
    if ((t) >= 1) RESCX(t); pv_d0(o, vbL + ((t) & 1) * (int)SHM_V, pa0, pa1, pa2, pa3); pv_d0(o + 4, vbH + ((t) & 1) * (int)SHM_V, pa0, pa1, pa2, pa3); } while (0)
    VLOAD(a, 0); asm volatile("s_waitcnt vmcnt(0)" ::: "memory"); VWRITE(0, a); __syncthreads();
    VLOAD(b, KVBLK);
    __syncthreads();
    for (int j = 1; j + 1 < NT; j += 2) {
      VLOAD(a, (j + 1) * KVBLK);
      if (j >= 3) XSTEP(j - 2);
      __syncthreads();
      asm volatile("s_waitcnt vmcnt(8)" ::: "memory"); VWRITE(1, b);
      __syncthreads();
      if (j + 2 < NT) VLOAD(b, (j + 2) * KVBLK);
      XSTEP(j - 1);
      __syncthreads();
      if (j + 2 < NT) asm volatile("s_waitcnt vmcnt(8)" ::: "memory"); else asm volatile("s_waitcnt vmcnt(0)" ::: "memory");
      VWRITE(0, a);
      __syncthreads();
    }
    XSTEP(NT - 3);
    __syncthreads();
    asm volatile("s_waitcnt vmcnt(0)" ::: "memory"); VWRITE(1, b);
    __syncthreads();
    XSTEP(NT - 2);
    __syncthreads();
    XSTEP(NT - 1);
#undef VLOAD
#undef VWRITE
#undef XSTEP
    asm volatile("s_waitcnt lgkmcnt(0)" ::: "memory");
    float rli[16];
#pragma unroll
    for (int r = 0; r < 16; ++r) rli[r] = __builtin_amdgcn_rcpf(LI[pw * 32 + crow(r, hi)]);
    float* Owl = Olo + (long)(pw * QBLK) * LDO; float* Owh = Ohi + (long)(pw * QBLK) * LDO;
#pragma unroll
    for (int r = 0; r < 16; ++r) { const int orow = crow(r, hi);
#pragma unroll
      for (int d0 = 0; d0 < 4; ++d0) { Owl[(long)orow * LDO + d0 * 32 + r32] = o[d0][r] * rli[r]; Owh[(long)orow * LDO + d0 * 32 + r32] = o[4 + d0][r] * rli[r]; } }
    asm volatile("s_waitcnt vmcnt(0)" ::: "memory"); __syncthreads();
  }
#undef RESCX
}
}

struct Args { const float* in[22]; float* out; unsigned char* ws; int ph_lo, ph_hi, li, pad; };
enum { I_X = 0, I_C, I_CTX, I_CCTX, I_WADA, I_BADA, I_WIN, I_LAMBDA, I_SUBLN, I_QKG, I_WBR, I_WGATE, I_BGATE, I_WO, I_LN1G, I_LN1B, I_WUP, I_CONVW, I_CONVB, I_WDOWN, I_LN2G, I_LN2B };

__device__ __forceinline__ const float* inp(int i) { int off = i * 8; asm volatile("" : "+s"(off));
    const GAS float* p = *(const GAS float* const __attribute__((address_space(4)))*)((const __attribute__((address_space(4))) char*)__builtin_amdgcn_kernarg_segment_ptr() + off);
    return (const float*)p; }
#define WSP(T, OFF) ((T*)(wsp + (OFF)))
#define PH_BEGIN size_t zoff_ = 0; asm volatile("" : "+s"(zoff_)); unsigned char* wsp = args.ws + zoff_; int tid_p = threadIdx.x; asm volatile("" : "+v"(tid_p)); const int tid = tid_p, lane = tid_p & 63; (void)tid; (void)lane

template <int MODE>
__device__ __forceinline__ void transpose_item(const float* W, int K, int N, bf16_t* WT, int row_off, LAS float* scr, int item, int lane) {
    const int nblk = N / 32, kb = item / nblk, nb = item - kb * nblk, k0 = 64 * kb, n0 = 32 * nb;
    if (MODE == 1) { const int isg = n0 >= DFF, f = n0 - isg * DFF; row_off = (f >> 7) * 256 + isg * 128 + (f & 127) - n0; }
    const bool il = (MODE == 2) && (n0 < 4096 || (n0 >= 8192 && n0 < 10752));
    float tv[32];
#pragma unroll
    for (int i = 0; i < 32; ++i) { const int kk = 2 * i + (lane >> 5); tv[i] = W[(size_t)(k0 + kk) * N + n0 + (lane & 31)]; }
#pragma unroll
    for (int i = 0; i < 32; ++i) { const int kk = 2 * i + (lane >> 5); scr[kk * 33 + (lane & 31)] = tv[i]; }
    LDS_WAIT(); asm volatile("" ::: "memory");
    const int c = lane & 7;
#pragma unroll
    for (int j = 0; j < 4; ++j) { const int n = (lane >> 3) + 8 * j; const LAS float* s = scr + (8 * c) * 33 + n;
        u32x4 o; o.x = pk2(s[0 * 33], s[1 * 33]); o.y = pk2(s[2 * 33], s[3 * 33]); o.z = pk2(s[4 * 33], s[5 * 33]); o.w = pk2(s[6 * 33], s[7 * 33]);
        int drow = row_off + n0 + n; if (il) { const int cn = n0 + n, d = cn & 127; drow = row_off + (cn & ~127) + 2 * (d & 63) + (d >> 6); }
        *(u32x4*)(WT + (size_t)drow * K + k0 + 8 * c) = o; }
    LDS_WAIT(); asm volatile("" ::: "memory");
}

__device__ __forceinline__ void ln_row(const float* yrow, const float* g, const float* bb, float* Xo, bf16_t* Ho, const float* sc, const float* sh, float* Oo, int lane, const float* yp = nullptr, const float* xrow = nullptr, const float* gate = nullptr) {
    f32x4 v[16]; float s = 0.f;
#pragma unroll
    for (int j = 0; j < 16; ++j) { const int c = 256 * j + 4 * lane;
        if (yp) { f32x4 a = *(const f32x4*)(yp + c);
#pragma unroll
            for (int sp = 1; sp < 8; ++sp) a += *(const f32x4*)(yp + (size_t)sp * 512 * DM + c);
            v[j] = *(const f32x4*)(xrow + c) * DN_ALPHA + *(const f32x4*)(gate + c) * a; }
        else v[j] = *(const f32x4*)(yrow + c);
        s += (v[j].x + v[j].y) + (v[j].z + v[j].w); }
    const float mean = wave_sum(s) * (1.f / DM); float s2 = 0.f;
#pragma unroll
    for (int j = 0; j < 16; ++j) { v[j] = v[j] - mean; s2 += (v[j].x * v[j].x + v[j].y * v[j].y) + (v[j].z * v[j].z + v[j].w * v[j].w); }
    const float rstd = 1.f / sqrtf(wave_sum(s2) * (1.f / DM) + NORM_EPS);
#pragma unroll
    for (int j = 0; j < 16; ++j) { const int c = 256 * j + 4 * lane;
        const f32x4 x = v[j] * rstd * *(const f32x4*)(g + c) + *(const f32x4*)(bb + c);
        if (Xo) *(f32x4*)(Xo + c) = x;
        if (Oo) *(f32x4*)(Oo + c) = x;
        if (Ho) { const f32x4 h = x * (*(const f32x4*)(sc + c) + 1.0f) + *(const f32x4*)(sh + c);
            u32x2 w; w.x = cvt_pk_bf16(h.x, h.y); w.y = cvt_pk_bf16(h.z, h.w); *(u32x2*)(Ho + c) = w; } }
}

__global__ void __launch_bounds__(NTHREADS, 2) fwd(Args args) {
    extern __shared__ __attribute__((aligned(16))) unsigned char lds_raw[];
    LAS unsigned char* lds = (LAS unsigned char*)lds_raw;
    const int tid0 = threadIdx.x, wave = __builtin_amdgcn_readfirstlane(tid0 >> 6);
    const int G = gridDim.x, bx = blockIdx.x;
    const int vcu = (G % 8 == 0) ? (bx % 8) * (G / 8) + bx / 8 : bx;
    const int gw = vcu * NWAVES + wave, NGW = G * NWAVES;
    unsigned* ctl = (unsigned*)(args.ws + WS_CTL);
    for (int u = tid0; u < (LDS_BYTES - LDSCTL_OFF) / 4; u += NTHREADS) ((LAS unsigned*)(lds + LDSCTL_OFF))[u] = 0u;
    __syncthreads();
    XcdBarrier bar; bar.bar = ctl + 4096; bar.x = 0; bar.st = nullptr;
    if (MK_N_LAUNCHES == 1) bar = xcd_barrier_post(ctl + 4096, (volatile LAS unsigned*)(lds + LDSCTL_OFF + 64));
    const int lo = args.ph_lo, hi = args.ph_hi;
#ifndef PHMASK
#define PHMASK 0xFFFFFFFFu
#endif
#define PHB(k) ((PHMASK >> (k)) & 1u)
#ifndef REPMASK
#define REPMASK 0u
#endif
#define REPN(k) (1 + (int)((REPMASK >> (k)) & 1u))
#define REP_BEGIN(k) for (int rep_ = 0; rep_ < REPN(k); ++rep_) {
#define REP_END(k) if (rep_ + 1 < REPN(k)) xcd_barrier(bar); }
#define IN(k) (lo <= (k) && (k) < hi)
#define SEAM(k) do { if (IN(k) && IN((k) + 1)) xcd_barrier(bar); } while (0)

    REP_BEGIN(0)
    if (PHB(0) && IN(0)) {
        PH_BEGIN;
        { LAS float* sv = (LAS float*)lds;
          float* MODP = WSP(float, WS_MODP); const float* pc = inp(I_C); const float* pcc = inp(I_CCTX); const float* wada = inp(I_WADA);
          LAS float* red = (LAS float*)(lds + 49152);
          for (int i = tid; i < 3 * DM; i += NTHREADS) { const int j = i / DM, k = i - j * DM; const float c = (j < 2) ? pc[j * DM + k] : pcc[k]; sv[i] = c * sigmoidf_(c); }
          __syncthreads();
          for (int it = bx; it < 768; it += G) {
              const int l = it / 384, r = it - l * 384, cg = r >> 1, kh = r & 1;
              const float* W = wada + (size_t)l * DM * NADA + cg * 128 + 4 * (lane & 31);
              const int kbase = kh * 2048 + wave * 256 + (lane >> 5);
              f32x4 a0 = {0.f, 0.f, 0.f, 0.f}, a1 = a0, a2 = a0;
#pragma unroll 8
              for (int i = 0; i < 128; ++i) { const int k = kbase + 2 * i; const f32x4 w = *(const f32x4*)(W + (size_t)k * NADA);
                  a0 += w * sv[k]; a1 += w * sv[DM + k]; a2 += w * sv[2 * DM + k]; }
#pragma unroll
              for (int j = 0; j < 4; ++j) { a0[j] += __shfl_xor(a0[j], 32); a1[j] += __shfl_xor(a1[j], 32); a2[j] += __shfl_xor(a2[j], 32); }
              if (lane < 32) { *(LAS f32x4*)(red + (wave * 3 + 0) * 128 + 4 * lane) = a0; *(LAS f32x4*)(red + (wave * 3 + 1) * 128 + 4 * lane) = a1; *(LAS f32x4*)(red + (wave * 3 + 2) * 128 + 4 * lane) = a2; }
              __syncthreads();
              if (tid < 384) { float s = 0.f;
#pragma unroll
                  for (int w8 = 0; w8 < 8; ++w8) s += red[w8 * 384 + tid];
                  const int j = tid >> 7, n = tid & 127;
                  MODP[((size_t)(l * 2 + kh) * 3 + j) * NADA + cg * 128 + n] = s; }
              __syncthreads();
          }
        }
        { LAS float* ct = (LAS float*)lds; LAS float* st = ct + 4096;
          for (int i = tid; i < 4096; i += NTHREADS) { const float a = (float)i * (1.0f / 2048.0f); ct[i] = cospif(a); st[i] = sinpif(a); }
          __syncthreads();
          const int gt = vcu * NTHREADS + tid, NGT = G * NTHREADS;
          bf16_t* FM = WSP(bf16_t, WS_F); bf16_t* FCTX = WSP(bf16_t, WS_FCTX); bf16_t* DC = WSP(bf16_t, WS_DC); float* ROPE = WSP(float, WS_ROPE);
          for (int i = gt; i < 4096 * 1024; i += NGT) { const int np = i >> 10, c8 = (i & 1023) * 8; const bool sn = c8 >= 4096; const int n0 = c8 & 4095;
              float v[8];
#pragma unroll
              for (int e = 0; e < 8; ++e) { const int idx = (np * (n0 + e)) & 4095; v[e] = sn ? -st[idx] * (1.0f / 64.0f) : ct[idx] * (1.0f / 64.0f); }
              u32x4 w; w.x = pk2(v[0], v[1]); w.y = pk2(v[2], v[3]); w.z = pk2(v[4], v[5]); w.w = pk2(v[6], v[7]);
              *(u32x4*)(FM + (size_t)np * 8192 + c8) = w; }
          for (int i = gt; i < 256 * 512; i += NGT) { const int np = i >> 9, c = i & 511; const bool sn = c >= 256; const int idx = ((np * (c & 255)) & 255) * 16;
              FCTX[i] = (bf16_t)f2bf(sn ? -st[idx] * (1.0f / 16.0f) : ct[idx] * (1.0f / 16.0f)); }
          for (int i = gt; i < 512 * 256; i += NGT) { const int r = i >> 8, c = i & 255; const bool sn = r >= 256; const int idx = (((r & 255) * c) & 255) * 16;
              DC[i] = (bf16_t)f2bf(sn ? st[idx] * (1.0f / 16.0f) : ct[idx] * (1.0f / 16.0f)); }
          for (int i = gt; i < 4096 * 64; i += NGT) { const int t = i >> 6, f = i & 63; const float pos = (f < 32) ? (float)(t >> 6) : (float)(t & 63);
              const float inv = exp2f(-(float)(f & 31) * (13.287712379549449f / 32.0f));
              double xr = (double)pos * (double)inv * 0.31830988618379067; xr -= 2.0 * floor(xr * 0.5);
              ROPE[2 * i] = cospif((float)xr); ROPE[2 * i + 1] = sinpif((float)xr); }
          __syncthreads();
        }
        { LAS float* scr = (LAS float*)(lds + wave * 16384);
          constexpr int IT_IN = 64 * 352, IT_G = 64 * 384, IT_B = 32 * 128, IT_O = 64 * 128, IT_UP = 64 * 688, IT_DN = 172 * 128;
          constexpr int IT_LAYER = IT_IN + IT_G + 3 * IT_B + IT_O + IT_UP + IT_DN;
          const float* p_win = inp(I_WIN); const float* p_wg = inp(I_WGATE); const float* p_wbr = inp(I_WBR); const float* p_wo = inp(I_WO); const float* p_wup = inp(I_WUP); const float* p_wdn = inp(I_WDOWN);
          for (int it = gw; it < NLAYER * IT_LAYER; it += NGW) {
              const int l = it / IT_LAYER; int r = it - l * IT_LAYER;
              unsigned char* wl = wsp + WS_W + (size_t)l * W_LAYER;
              if (r < IT_IN) { transpose_item<2>(p_win + (size_t)l * DM * DIN, DM, DIN, (bf16_t*)(wl + W_1), 0, scr, r, lane); continue; } r -= IT_IN;
              if (r < IT_G) { transpose_item<0>(p_wg + (size_t)l * DM * NGATE, DM, NGATE, (bf16_t*)(wl + W_1), DIN, scr, r, lane); continue; } r -= IT_G;
              if (r < 3 * IT_B) { const int n = r / IT_B; r -= n * IT_B; transpose_item<0>(p_wbr + ((size_t)l * 3 + n) * BW * DM, BW, DM, (bf16_t*)(wl + W_B) + (size_t)n * DM * BW, 0, scr, r, lane); continue; } r -= 3 * IT_B;
              if (r < IT_O) { transpose_item<0>(p_wo + (size_t)l * DM * DM, DM, DM, (bf16_t*)(wl + W_O), 0, scr, r, lane); continue; } r -= IT_O;
              if (r < IT_UP) { transpose_item<1>(p_wup + (size_t)l * DM * NUP, DM, NUP, (bf16_t*)(wl + W_UP), 0, scr, r, lane); continue; } r -= IT_UP;
              transpose_item<0>(p_wdn + (size_t)l * DFF * DM, DFF, DM, (bf16_t*)(wl + W_DN), 0, scr, r, lane);
          }
        }
    }
        REP_END(0)
    SEAM(0);
    REP_BEGIN(1)
    if (PHB(1) && IN(1)) {
        PH_BEGIN;
        const int gt = vcu * NTHREADS + tid, NGT = G * NTHREADS;
        float* MODP = WSP(float, WS_MODP); float* MOD = WSP(float, WS_MOD); bf16_t* H = WSP(bf16_t, WS_H); const float* bada = inp(I_BADA); const float* px = inp(I_X); const float* pctx = inp(I_CTX);
        for (int i = gt; i < NLAYER * 3 * NADA; i += NGT) { const int l = i / (3 * NADA), r = i - l * 3 * NADA, j = r / NADA, n = r - j * NADA;
            MOD[i] = MODP[((size_t)(l * 2 + 0) * 3 + j) * NADA + n] + MODP[((size_t)(l * 2 + 1) * 3 + j) * NADA + n] + bada[l * NADA + n]; }
        for (int i = gt; i < M * (DM / 4); i += NGT) { const int row = i >> 10, c4 = (i & 1023) * 4; const int b = row / LT, p = row - b * LT, j = (p < CTX) ? 2 : b;
            const size_t o0 = ((size_t)(0 * 2 + 0) * 3 + j) * NADA, o1 = ((size_t)(0 * 2 + 1) * 3 + j) * NADA;
            const f32x4 sh = *(const f32x4*)(MODP + o0 + c4) + *(const f32x4*)(MODP + o1 + c4) + *(const f32x4*)(bada + c4);
            const f32x4 sc = *(const f32x4*)(MODP + o0 + DM + c4) + *(const f32x4*)(MODP + o1 + DM + c4) + *(const f32x4*)(bada + DM + c4);
            const f32x4 x = *(const f32x4*)((p < CTX) ? pctx + ((size_t)(b * CTX + p)) * DM + c4 : px + ((size_t)(b * SEQ + p - CTX)) * DM + c4);
            const f32x4 h = x * (sc + 1.0f) + sh;
            u32x2 w; w.x = cvt_pk_bf16(h.x, h.y); w.y = cvt_pk_bf16(h.z, h.w); *(u32x2*)(H + (size_t)row * DM + c4) = w; }
    }
        REP_END(1)
    SEAM(1);

#pragma unroll 1
    for (int l = 0; l < NLAYER; ++l) {
        const int P0 = PH_PRO + l * PH_PER_LAYER;
        const bool lastl = (l == NLAYER - 1);
#define WL (wsp + WS_W + (size_t)l * W_LAYER)
#define MODL (WSP(float, WS_MOD) + (size_t)l * 3 * NADA)
        const float lam_init = 0.8f - 0.6f * expf(-0.3f * (float)l);

        REP_BEGIN(2)
        if (PHB(2) && IN(P0 + 0)) {
            PH_BEGIN;
            pg8::Gemm g{WSP(bf16_t, WS_H), (const bf16_t*)(WL + W_1), DM, DM, DM, 0, 0};
            pg8::TileOrder<1> S; S.init(M / 256, N1 / 256, 1, G, bx, lastl, lastl ? 40 : 0);
            pg8::EpiProj E{WSP(bf16_t, WS_PG), inp(I_BGATE) + (size_t)l * NGATE, inp(I_QKG) + (size_t)l * 2 * 128, WSP(float, WS_ROPE), (LAS float*)(lds + LDS_EX_OFF), WSP(bf16_t, WS_KV)};
            pg8::gemm_phase<pg8::EpiProj, pg8::TileOrder<1>>(lds, g, S, E);
        }
        REP_END(2)
        SEAM(P0 + 0);
        REP_BEGIN(3)
        if (PHB(3) && IN(P0 + 1)) {
            PH_BEGIN;
            bf16_t* PG = WSP(bf16_t, WS_PG);
            { pg8::Gemm g{WSP(bf16_t, WS_DC), PG + C_BU, 256, N1, 256, 0, 256};
              pg8::TileOrder<1> S; S.init(2, M / 256, 8, G, bx);
              pg8::EpiF1 E{WSP(bf16_t, WS_YT), WSP(bf16_t, WS_YTC)};
              pg8::gemm_phase<pg8::EpiF1, pg8::TileOrder<1>>(lds, g, S, E);
            }
        }
        REP_END(3)
        SEAM(P0 + 1);
        REP_BEGIN(4)
        if (PHB(4) && IN(P0 + 2)) {
            PH_BEGIN;
            const bf16_t* PG = WSP(bf16_t, WS_PG); const bf16_t* KVB = WSP(bf16_t, WS_KV); float* OA1 = WSP(float, WS_OA1); float* OA2 = WSP(float, WS_OA2); bf16_t* BR = WSP(bf16_t, WS_BR);
            const float* lp = inp(I_LAMBDA) + (size_t)l * 4 * 128; const float* sgp = inp(I_SUBLN) + (size_t)l * 256;
            for (int pass = 0; pass < (lastl ? 2 : 4); ++pass) {
                const int nit = (pass == 0) ? 512 : (pass == 1) ? 256 : (pass == 2) ? 32 : 16;
                const int c0 = (pass == 3) ? (bx + G - (32 % G)) % G : bx;
                for (int L = c0; L < nit; L += G) {
                    int it = L; if (pass < 2) { const int q = nit / 8; it = (L % 8) * q + L / 8; }
                    const bool grp = (pass & 1);
                    int b, qrow, seq, hsel;
                    if (pass == 0) { b = it >> 8; const int r = it & 255; hsel = (r >> 6) * 4 + ((r >> 4) & 3); qrow = b * LT + CTX + (r & 15) * 256; seq = LT; }
                    else if (pass == 1) { b = it >> 7; hsel = (it >> 4) & 7; qrow = b * LT + CTX + (it & 15) * 256; seq = LT; }
                    else if (pass == 2) { b = it >> 4; hsel = it & 15; qrow = b * LT; seq = CTX; }
                    else { b = it >> 3; hsel = it & 7; qrow = b * LT; seq = CTX; }
                    if (!grp) { const int kvh = hsel >> 2;
                        att::attn_dense_body(PG + (size_t)qrow * N1 + C_CQ + hsel * 128, KVB + (size_t)(b * 40 + 32 + kvh) * LT * 128, KVB + (size_t)(b * 40 + 36 + kvh) * LT * 128,
                                             (void*)(BR + (size_t)2 * M * BW + (size_t)qrow * BW + hsel * 128), 1, seq, (char*)lds_raw);
                        __syncthreads(); }
                    else for (int j = 0; j < 4; ++j) { const int mp = j >> 1, rh = j & 1;
                        float* Ol = (mp ? OA2 : OA1) + (size_t)(qrow + rh * 128) * BW + hsel * 256;
                        att::attn_diff_body(PG + (size_t)(qrow + rh * 128) * N1 + C_AQ + hsel * 256 + mp * 128, KVB + (size_t)(b * 40 + hsel * 2 + mp) * LT * 128,
                                            KVB + (size_t)(b * 40 + 16 + hsel * 2) * LT * 128, KVB + (size_t)(b * 40 + 17 + hsel * 2) * LT * 128, Ol, Ol + 128, seq, (char*)lds_raw, (char*)lds_raw + LDS_EX_OFF); }
                    if (grp) {
                        VM_WAIT();
                        int lz = tid & 63; asm volatile("" : "+v"(lz));
                        const float d1 = wave_sum(lp[lz] * lp[128 + lz] + lp[64 + lz] * lp[192 + lz]);
                        const float d2 = wave_sum(lp[256 + lz] * lp[384 + lz] + lp[320 + lz] * lp[448 + lz]);
                        const float lam = expf(d1) - expf(d2) + lam_init;
                        const f32x4 sgv = *(const f32x4*)(sgp + 4 * lz) * (1.0f - lam_init);
                        for (int r0 = 0; r0 < 32; r0 += 8) { f32x4 dv[8];
#pragma unroll
                            for (int r = 0; r < 8; ++r) { const size_t off = (size_t)(qrow + wave * 32 + r0 + r) * BW + hsel * 256 + 4 * lz;
                                dv[r] = *(const f32x4*)(OA1 + off) - *(const f32x4*)(OA2 + off) * lam; }
#pragma unroll
                            for (int r = 0; r < 8; ++r) { const size_t off = (size_t)(qrow + wave * 32 + r0 + r) * BW + hsel * 256 + 4 * lz;
                                const f32x4 d = dv[r];
                                const float ss = wave_sum((d.x * d.x + d.y * d.y) + (d.z * d.z + d.w * d.w));
                                const float rr = 1.0f / sqrtf(ss * (1.0f / 256.0f) + NORM_EPS);
                                const f32x4 o = d * rr * sgv;
                                u32x2 w; w.x = cvt_pk_bf16(o.x, o.y); w.y = cvt_pk_bf16(o.z, o.w); *(u32x2*)(BR + off) = w; } }
                    }
                }
            }
            VM_WAIT(); __syncthreads();
            { pg8::Gemm g{WSP(bf16_t, WS_F), WSP(bf16_t, WS_YT), 8192, 8192, 8192, 0, (size_t)256 * 8192};
              pg8::OrdZ S{G, bx, 256, 4};
              pg8::EpiF2 E{BR + (size_t)1 * M * BW, CTX};
              pg8::gemm_phase<pg8::EpiF2, pg8::OrdZ>(lds, g, S, E);
            }
            if (!lastl) {
              pg8::Gemm g{WSP(bf16_t, WS_FCTX), WSP(bf16_t, WS_YTC), 512, 512, 512, 0, (size_t)256 * 512};
              pg8::OrdZ S{G, bx, 16, 0};
              pg8::EpiF2 E{BR + (size_t)1 * M * BW, 0};
              pg8::gemm_phase<pg8::EpiF2, pg8::OrdZ>(lds, g, S, E);
            }
        }
        REP_END(4)
        SEAM(P0 + 2);
        REP_BEGIN(5)
        if (PHB(5) && IN(P0 + 3)) {
            PH_BEGIN;
            pg8::Gemm g{WSP(bf16_t, WS_BR), (const bf16_t*)(WL + W_B), BW, BW, BW, (size_t)M * BW, (size_t)DM * BW};
            pg8::TileOrder<3> S; S.init(M / 256, DM / 256, 1, G, bx, lastl);
            pg8::EpiBranch E{WSP(bf16_t, WS_PG) + C_G, WSP(bf16_t, WS_MB)};
            pg8::gemm_phase<pg8::EpiBranch, pg8::TileOrder<3>>(lds, g, S, E);
        }
        REP_END(5)
        SEAM(P0 + 3);
        REP_BEGIN(6)
        if (PHB(6) && IN(P0 + 4)) {
            PH_BEGIN;
            pg8::Gemm g{WSP(bf16_t, WS_MB), (const bf16_t*)(WL + W_O), DM, DM, DM, 0, 0};
            pg8::EpiResid E{WSP(float, WS_X), WSP(float, WS_Y), MODL + 2 * DM, WSP(float, WS_YP), (l == 0) ? inp(I_X) : nullptr, inp(I_CTX)};
            pg8::SplitOrder S; S.init(G, bx, 8, 8, lastl ? 0 : 256); pg8::gemm_phase<pg8::EpiResid, pg8::SplitOrder, true>(lds, g, S, E);
        }
        REP_END(6)
        SEAM(P0 + 4);
        REP_BEGIN(7)
        if (PHB(7) && IN(P0 + 5)) {
            PH_BEGIN;
            const float* Y = WSP(float, WS_Y); float* X = WSP(float, WS_X); bf16_t* H = WSP(bf16_t, WS_H); const float* modl = MODL; const float* YP = WSP(float, WS_YP); const float* ctxin = inp(I_CTX);
            const float* g1 = inp(I_LN1G) + (size_t)l * DM; const float* b1 = inp(I_LN1B) + (size_t)l * DM;
            for (int row = gw; row < M; row += NGW) { const int b = row / LT, p = row - b * LT, j = (p < CTX) ? 2 : b;
                if (lastl && p < CTX) continue;
                const bool cp = p < CTX;
                ln_row(Y + (size_t)row * DM, g1, b1, X + (size_t)row * DM, H + (size_t)row * DM, modl + (size_t)j * NADA + 4 * DM, modl + (size_t)j * NADA + 3 * DM, nullptr, lane,
                       cp ? YP + (size_t)(b * 256 + p) * DM : nullptr, ctxin + (size_t)(b * CTX + (cp ? p : 0)) * DM, modl + (size_t)j * NADA + 2 * DM); }
        }
        REP_END(7)
        SEAM(P0 + 5);
        REP_BEGIN(8)
        if (PHB(8) && IN(P0 + 6)) {
            PH_BEGIN;
            pg8::Gemm g{WSP(bf16_t, WS_H), (const bf16_t*)(WL + W_UP), DM, DM, DM, 0, 0};
            pg8::TileOrder<1> S; S.init(M / 256, NUP / 256, 1, G, bx, lastl);
            pg8::EpiConv E{WSP(bf16_t, WS_U2), inp(I_CONVW) + (size_t)l * 3 * DFF, inp(I_CONVB) + (size_t)l * DFF, WSP(float, WS_AE), WSP(float, WS_CP), WSP(float, WS_GP), (LAS float*)(lds + LDS_EX_OFF)};
            pg8::gemm_phase<pg8::EpiConv, pg8::TileOrder<1>>(lds, g, S, E);
        }
        REP_END(8)
        SEAM(P0 + 6);
        REP_BEGIN(9)
        if (PHB(9) && IN(P0 + 7)) {
            PH_BEGIN;
            bf16_t* U2 = WSP(bf16_t, WS_U2); const float* AE = WSP(float, WS_AE); const float* CP = WSP(float, WS_CP); const float* GP = WSP(float, WS_GP);
            const float* cw = inp(I_CONVW) + (size_t)l * 3 * DFF;
            const int gt = vcu * NTHREADS + tid, NGT = G * NTHREADS;
            for (int idx = gt; idx < 34 * 2 * (DFF / 4); idx += NGT) { const int te = idx / (DFF / 4), f4 = (idx - te * (DFF / 4)) * 4, tile = te >> 1, e = te & 1, pt = tile % 17;
                if (lastl && pt == 0) continue;
                f32x4 c = *(const f32x4*)(CP + (size_t)te * DFF + f4); const f32x4 g = *(const f32x4*)(GP + (size_t)te * DFF + f4);
                if (e == 0 && pt >= 2) c += *(const f32x4*)(cw + f4) * *(const f32x4*)(AE + (size_t)((tile - 1) * 2 + 1) * DFF + f4);
                if (e == 1 && pt >= 1 && pt <= 15) c += *(const f32x4*)(cw + 2 * DFF + f4) * *(const f32x4*)(AE + (size_t)((tile + 1) * 2 + 0) * DFF + f4);
                const f32x2 g0 = gelu_pk((f32x2){c[0], c[1]}), g1 = gelu_pk((f32x2){c[2], c[3]});
                u32x2 w; w.x = cvt_pk_bf16(g0.x * g[0], g0.y * g[1]); w.y = cvt_pk_bf16(g1.x * g[2], g1.y * g[3]);
                *(u32x2*)(U2 + (size_t)(tile * 256 + e * 255) * DFF + f4) = w; }
        }
        REP_END(9)
        SEAM(P0 + 7);
        REP_BEGIN(10)
        if (PHB(10) && IN(P0 + 8)) {
            PH_BEGIN;
            pg8::Gemm g{WSP(bf16_t, WS_U2), (const bf16_t*)(WL + W_DN), DFF, DFF, DFF, 0, 0};
            pg8::EpiResid E{WSP(float, WS_X), WSP(float, WS_Y), MODL + 5 * DM, WSP(float, WS_YP), nullptr, nullptr};
            pg8::SplitOrder S; S.init(G, bx, 22, 20, lastl ? 0 : 256); pg8::gemm_phase<pg8::EpiResid, pg8::SplitOrder, true>(lds, g, S, E);
        }
        REP_END(10)
        SEAM(P0 + 8);
        REP_BEGIN(11)
        if (PHB(11) && IN(P0 + 9)) {
            PH_BEGIN;
            const float* Y = WSP(float, WS_Y); float* X = WSP(float, WS_X); bf16_t* H = WSP(bf16_t, WS_H); float* outp = args.out; const float* YP = WSP(float, WS_YP);
            const float* g2 = inp(I_LN2G) + (size_t)l * DM; const float* b2 = inp(I_LN2B) + (size_t)l * DM;
            const float* modn = WSP(float, WS_MOD) + (size_t)(l + 1 < NLAYER ? l + 1 : l) * 3 * NADA;
            for (int row = gw; row < M; row += NGW) { const int b = row / LT, p = row - b * LT, j = (p < CTX) ? 2 : b;
                if (!lastl) ln_row(Y + (size_t)row * DM, g2, b2, X + (size_t)row * DM, H + (size_t)row * DM, modn + (size_t)j * NADA + 1 * DM, modn + (size_t)j * NADA + 0 * DM, nullptr, lane,
                                   (p < CTX) ? YP + (size_t)(b * 256 + p) * DM : nullptr, X + (size_t)row * DM, MODL + (size_t)j * NADA + 5 * DM);
                else if (p >= CTX) ln_row(Y + (size_t)row * DM, g2, b2, nullptr, nullptr, nullptr, nullptr, outp + ((size_t)(b * SEQ + p - CTX)) * DM, lane); }
        }
        REP_END(11)
        if (!lastl) SEAM(P0 + 9);
    }
#undef IN
#undef SEAM
}

extern "C" void kernel_launch(void* const* d_in, const int* in_sizes, int n_in, void* d_out, int out_size, void* d_ws, size_t ws_size, hipStream_t stream) {
    static int grid = 0;
    if (grid == 0) {
        if (n_in != 22 || in_sizes[0] != NB * SEQ * DM || out_size != NB * SEQ * DM || ws_size < WS_END) {
            fprintf(stderr, "kernel_launch: shape mismatch: n_in %d in0 %d out %d ws %zu (need %zu)\n", n_in, n_in > 0 ? in_sizes[0] : -1, out_size, ws_size, (size_t)WS_END); grid = -1; return; }
        int dev = 0, cus = 0, per_cu = 0;
        if (hipGetDevice(&dev) != hipSuccess || hipDeviceGetAttribute(&cus, hipDeviceAttributeMultiprocessorCount, dev) != hipSuccess) { grid = -1; return; }
        if (hipFuncSetAttribute((const void*)fwd, hipFuncAttributeMaxDynamicSharedMemorySize, LDS_BYTES) != hipSuccess) { fprintf(stderr, "kernel_launch: hipFuncSetAttribute failed\n"); grid = -1; return; }
        if (hipOccupancyMaxActiveBlocksPerMultiprocessor(&per_cu, (const void*)fwd, NTHREADS, LDS_BYTES) != hipSuccess || per_cu < 1) fprintf(stderr, "kernel_launch: occupancy query reports %d\n", per_cu);
        (void)hipGetLastError();
        grid = cus;
    }
    if (grid < 0) return;
    if (hipMemsetAsync((char*)d_ws + WS_CTL, 0, CTL_ZERO_BYTES, stream) != hipSuccess) return;
    Args a{};
    for (int i = 0; i < 22; ++i) a.in[i] = (const float*)d_in[i];
    a.out = (float*)d_out; a.ws = (unsigned char*)d_ws;
    if (MK_N_LAUNCHES == 1) { a.ph_lo = 0; a.ph_hi = NPH; a.li = 0; hipLaunchKernelGGL(fwd, dim3(grid), dim3(NTHREADS), LDS_BYTES, stream, a); }
    else for (int p = 0; p < NPH; ++p) { a.ph_lo = p; a.ph_hi = p + 1; a.li = p; hipLaunchKernelGGL(fwd, dim3(grid), dim3(NTHREADS), LDS_BYTES, stream, a); }
}
```

```cpp
#include <hip/hip_runtime.h>
#include <cstdio>
#include <cstdint>

#ifndef MK_N_LAUNCHES
#define MK_N_LAUNCHES 1
#endif

#define LAS __attribute__((address_space(3)))
#define GAS __attribute__((address_space(1)))
typedef unsigned short bf16_t;
typedef short bf16x8 __attribute__((ext_vector_type(8)));
typedef short s16x4 __attribute__((ext_vector_type(4)));
typedef float f32x2 __attribute__((ext_vector_type(2)));
typedef float f32x4 __attribute__((ext_vector_type(4)));
typedef float f32x16 __attribute__((ext_vector_type(16)));
typedef unsigned u32x2 __attribute__((ext_vector_type(2)));
typedef unsigned u32x4 __attribute__((ext_vector_type(4)));

constexpr int DM = 4096, NB = 2, SEQ = 4096, CTX = 256, LT = SEQ + CTX, M = NB * LT;
constexpr int DIN = 11264, NGATE = 12288, N1 = DIN + NGATE, DFF = 11008, NUP = 2 * DFF, BW = 2048;
constexpr int C_AQ = 0, C_AK = 2048, C_AV = 4096, C_BU = 6144, C_CQ = 8192, C_CK = 10240, C_CV = 10752, C_G = 11264;
constexpr int NLAYER = 2, NADA = 6 * DM;
constexpr float NORM_EPS = 1e-6f;
constexpr float DN_ALPHA = 1.4142135623730951f;
constexpr int NWAVES = 8, NTHREADS = 512;
constexpr int PH_PRO = 2, PH_PER_LAYER = 10, NPH = PH_PRO + NLAYER * PH_PER_LAYER;

constexpr size_t MiB = 1ull << 20;
constexpr size_t WS_CTL = 0, CTL_ZERO_BYTES = 1 * MiB;
constexpr size_t WS_MODP = 1 * MiB;
constexpr size_t WS_MOD = 3 * MiB;
constexpr size_t WS_ROPE = 4 * MiB;
constexpr size_t WS_DC = 6 * MiB;
constexpr size_t WS_FCTX = 6 * MiB + 512 * 1024;
constexpr size_t WS_F = 8 * MiB;
constexpr size_t WS_YF = 40 * MiB;
constexpr size_t WS_W = 72 * MiB;
constexpr size_t W_1 = 0, W_B = 184 * MiB, W_O = 232 * MiB, W_UP = 264 * MiB, W_DN = 436 * MiB, W_LAYER = 522 * MiB;
constexpr size_t WS_X = 1116 * MiB;
constexpr size_t WS_Y = 1252 * MiB;
constexpr size_t WS_H = 1388 * MiB;
constexpr size_t WS_MB = 1456 * MiB;
constexpr size_t WS_PG = 1524 * MiB;
constexpr size_t WS_AG = WS_PG;
constexpr size_t WS_OA1 = 1915 * MiB, WS_OA2 = 1983 * MiB;
constexpr size_t WS_BR = 2051 * MiB;
constexpr size_t WS_U2 = WS_OA1;
constexpr size_t WS_YT = 2153 * MiB;
constexpr size_t WS_YTC = 2217 * MiB;
constexpr size_t WS_AE = 2221 * MiB, WS_CP = 2224 * MiB, WS_GP = 2227 * MiB;
constexpr size_t WS_YP = 2230 * MiB;
constexpr size_t WS_KV = 2294 * MiB;
constexpr size_t WS_END = 2380 * MiB;

constexpr int RING_BYTES = 131072, LDSCTL_OFF = RING_BYTES, LDS_EX_OFF = RING_BYTES + 1024, LDS_BYTES = 147456;

#define RLX_AGENT __ATOMIC_RELAXED, __HIP_MEMORY_SCOPE_AGENT
#define LDS_WAIT() asm volatile("s_waitcnt lgkmcnt(0)" ::: "memory")
#define VM_WAIT() asm volatile("s_waitcnt vmcnt(0)" ::: "memory")
__device__ __forceinline__ unsigned f2bf(float f) { unsigned u = __builtin_bit_cast(unsigned, f); return (u + 0x7fffu + ((u >> 16) & 1u)) >> 16; }
__device__ __forceinline__ unsigned pk2(float lo, float hi) { return f2bf(lo) | (f2bf(hi) << 16); }
__device__ __forceinline__ float bflo(unsigned w) { return __builtin_bit_cast(float, w << 16); }
__device__ __forceinline__ float bfhi(unsigned w) { return __builtin_bit_cast(float, w & 0xffff0000u); }
__device__ __forceinline__ unsigned cvt_pk_bf16(float lo, float hi) { unsigned r; asm volatile("v_cvt_pk_bf16_f32 %0, %1, %2" : "=v"(r) : "v"(lo), "v"(hi)); return r; }
__device__ __forceinline__ float wave_sum(float v) {
#pragma unroll
    for (int o = 1; o < 64; o <<= 1) v += __shfl_xor(v, o);
    return v;
}
__device__ __forceinline__ float half_sum(float v) {
#pragma unroll
    for (int o = 1; o < 32; o <<= 1) v += __shfl_xor(v, o);
    return v;
}
__device__ __forceinline__ f32x2 gelu_pk(f32x2 v) {
    const f32x2 av = __builtin_elementwise_abs(v), d = av * 0.2316418882f + 1.0f;
    f32x2 t; t.x = __builtin_amdgcn_rcpf(d.x); t.y = __builtin_amdgcn_rcpf(d.y);
    f32x2 q = t * 0.5307027145f + (-0.7265760135f); q = q * t + 0.7107068705f; q = q * t + (-0.142248368f); q = q * t + 0.127414796f; q = q * t;
    const f32x2 s = (v * v) * (-0.72134752044f);
    f32x2 e; e.x = __builtin_amdgcn_exp2f(s.x); e.y = __builtin_amdgcn_exp2f(s.y);
    const f32x2 m = v * (q * e), r = v - m;
    f32x2 o; o.x = v.x < 0.f ? m.x : r.x; o.y = v.y < 0.f ? m.y : r.y; return o;
}
__device__ __forceinline__ float sigmoidf_(float z) { return __builtin_amdgcn_rcpf(1.0f + __builtin_amdgcn_exp2f(-1.4426950408889634f * z)); }

#define XB_TMO      128
#define XB_XCNT(j)  (256  + 64 * (j))
#define XB_XSUB(j)  (1280 + 64 * (j))
#define XB_XGEN(j)  (2304 + 64 * (j))
#define XB_TOP      3328
#define XB_TOPGEN   3392
#define XCD_BAR_WORDS 3456
#define XB_SPIN_CAP (1u << 18)
__device__ __forceinline__ unsigned xb_ld(unsigned* p)              { return __hip_atomic_load(p, __ATOMIC_RELAXED, __HIP_MEMORY_SCOPE_AGENT); }
__device__ __forceinline__ unsigned xb_add(unsigned* p, unsigned v) { return __hip_atomic_fetch_add(p, v, __ATOMIC_RELAXED, __HIP_MEMORY_SCOPE_AGENT); }
__device__ __forceinline__ unsigned xb_xcc_id() { return (unsigned)__builtin_amdgcn_s_getreg((3 << 11) | 20) & 0xFu; }
#define XB_SPIN(cond, bar) do { unsigned _sp = 0; while (cond) { __builtin_amdgcn_s_sleep(1); \
    if ((++_sp & 255u) == 0u) { if (xb_ld(&(bar)[XB_TMO])) break; if (_sp > XB_SPIN_CAP) { atomicAdd(&(bar)[XB_TMO], 1u); break; } } } } while (0)
struct XcdBarrier { unsigned* bar; unsigned x; volatile LAS unsigned* st; };
__device__ __forceinline__ XcdBarrier xcd_barrier_post(unsigned* bar, volatile LAS unsigned* st) {
    XcdBarrier b; b.bar = bar; b.x = xb_xcc_id(); b.st = st;
    if (threadIdx.x == 0) (void)xb_add(&bar[XB_XCNT(b.x)], 1u);
    return b;
}
__device__ __forceinline__ void xcd_barrier_complete(unsigned* bar, unsigned x, unsigned& nloc, unsigned& nx) {
    const unsigned G = gridDim.x * gridDim.y * gridDim.z;
    unsigned sum, cnt, mine, sp = 0u;
    for (;;) {
        sum = 0u; cnt = 0u; mine = 0u;
#pragma unroll
        for (unsigned j = 0; j < 16; ++j) { const unsigned c = xb_ld(&bar[XB_XCNT(j)]); sum += c; cnt += (c > 0u) ? 1u : 0u; mine = (j == x) ? c : mine; }
        if (sum == G) break;
        __builtin_amdgcn_s_sleep(1);
        if ((++sp & 255u) == 0u) { if (xb_ld(&bar[XB_TMO])) break; if (sp > XB_SPIN_CAP) { atomicAdd(&bar[XB_TMO], 1u); break; } }
    }
    nloc = mine > 0u ? mine : 1u; nx = cnt > 0u ? cnt : 1u;
}
__device__ __forceinline__ void xcd_barrier(const XcdBarrier& b) {
    asm volatile("s_waitcnt vmcnt(0)" ::: "memory");
    __syncthreads();
    if (threadIdx.x == 0) {
        unsigned* bar = b.bar;
        __builtin_amdgcn_s_waitcnt(0);
        unsigned nloc = b.st[0], nx = b.st[1];
        if (nloc == 0u) { xcd_barrier_complete(bar, b.x, nloc, nx); b.st[0] = nloc; b.st[1] = nx; }
        const unsigned old = xb_add(&bar[XB_XSUB(b.x)], 1u);
        const unsigned gen = old / nloc;
        if (old + 1u == (gen + 1u) * nloc) {
            __builtin_amdgcn_fence(__ATOMIC_RELEASE, "agent");
            asm volatile("s_waitcnt vmcnt(0)" ::: "memory");
            const unsigned og = xb_add(&bar[XB_TOP], 1u);
            const unsigned tg = og / nx;
            if (og + 1u == (tg + 1u) * nx) xb_add(&bar[XB_TOPGEN], 1u);
            else XB_SPIN(xb_ld(&bar[XB_TOPGEN]) == tg, bar);
            __builtin_amdgcn_fence(__ATOMIC_ACQUIRE, "agent");
            xb_add(&bar[XB_XGEN(b.x)], 1u);
            asm volatile("s_waitcnt vmcnt(0)" ::: "memory");
        } else {
            XB_SPIN(xb_ld(&bar[XB_XGEN(b.x)]) == gen, bar);
            __builtin_amdgcn_fence(__ATOMIC_ACQUIRE, "agent");
            asm volatile("s_waitcnt vmcnt(0)" ::: "memory");
        }
    }
    __syncthreads();
}

namespace pg8 {
constexpr int BM = 256, BK = 64, HALF = 128, HTB = HALF * BK * 2, STAGE_BYTES = 8 * HTB, NXCD = 8, WGM = 8;
__host__ __device__ __forceinline__ int lds_byte(int r, int c) { const int st = (r >> 4) * 2 + (c >> 5), rr = r & 15, cc = c & 31, ob = rr * 64 + cc * 2; return st * 1024 + (ob ^ (((ob >> 9) & 1) << 5)); }
__host__ __device__ __forceinline__ void stage_rc(int b, int& R, int& C) { const int st = b / 1024, sb = b % 1024, swz = sb ^ (((sb >> 9) & 1) << 5); R = (st >> 1) * 16 + swz / 64; C = (st & 1) * 32 + (swz % 64) / 2; }
__host__ __device__ __forceinline__ int perm32(int rho) { const int n = rho >> 4, i = rho & 15; return 8 * (i >> 2) + 4 * n + (i & 3); }

struct Unit { int pm, pn, z, kb, nt; };
struct Gemm { const bf16_t* A; const bf16_t* Bt; int lda, ldb, K; size_t zA, zB; };

template <int SEG> struct TileOrder {
    int nM, nN, nz, nwg, G, c, lat, nextra;
    __device__ __forceinline__ void init(int nM_, int nN_, int nz_, int G_, int c_, int lat_ = 0, int nextra_ = 0) { lat = lat_; nextra = nextra_; nM = lat ? 32 : nM_; nN = nN_; nz = nz_; nwg = nM * nN * nz; G = G_; c = c_; }
    __device__ __forceinline__ bool next(int i, Unit& u) const {
        const int ti = i / SEG, sg = i - ti * SEG;
        const long L = (long)ti * G + c; if (L >= nwg + nextra) return false;
        u.kb = 0; u.nt = 0;
        if (L >= nwg) { const int idx = (int)L - nwg, t = idx / 20, j = idx - t * 20; u.pm = t * 17; u.pn = j < 16 ? 8 + j : 24 + j; u.z = 0; return true; }
        int wgid = (int)L; { const int q = nwg / NXCD, r = nwg % NXCD, xcd = wgid % NXCD, off = wgid / NXCD; wgid = (xcd < r ? xcd * (q + 1) : r * (q + 1) + (xcd - r) * q) + off; }
        const int per = nM * nN, zz = wgid / per; wgid -= zz * per;
        const int nig = WGM * nN, gid = wgid / nig, fm = gid * WGM, gsz = (nM - fm) < WGM ? (nM - fm) : WGM;
        int pm = fm + ((wgid % nig) % gsz); if (lat) pm += 1 + (pm >= 16);
        u.pm = pm; u.pn = (wgid % nig) / gsz; u.z = (SEG > 1) ? sg : zz; return true;
    }
};

struct SplitOrder { int G, c, nta, ntb, nsub;
    __device__ __forceinline__ void init(int G_, int c_, int nta_, int ntb_, int nsub_) { G = G_; c = c_; nta = nta_; ntb = ntb_; nsub = nsub_; }
    __device__ __forceinline__ bool next(int i, Unit& u) const {
        const int L = i * G + c;
        const bool ok = L < 512 + nsub;
        const int w = (L & 7) * 64 + (L >> 3);
        const int gid = w >> 7, r = w & 127; int pm_l = gid * 8 + (r & 7); pm_l += 1 + (pm_l >= 16); const int pn_l = r >> 3;
        const int idx = L - 512, tile = idx >> 3, sp = idx & 7;
        const bool lat = L < 512;
        const int pm = lat ? pm_l : (tile >> 4) * 17, pn = lat ? pn_l : (tile & 15), z = lat ? 0 : sp;
        const int nt = lat ? 0 : (sp < 6 ? nta : ntb), kb = lat ? 0 : (sp < 6 ? sp * nta : 6 * nta + (sp - 6) * ntb) * BK;
        u.pm = pm; u.pn = pn; u.z = z; u.kb = kb; u.nt = nt;
        return ok;
    }
};

template <class Epi, class Sched, bool VARK = false, bool ALIGN_EPI = true, bool SP2 = true>
__device__ __forceinline__ void gemm_phase(LAS unsigned char* lds, const Gemm g, const Sched& S, const Epi& E) {
    int tid_ = threadIdx.x; asm volatile("" : "+v"(tid_));
    const int tid = tid_, wid = __builtin_amdgcn_readfirstlane(tid >> 6), lane = tid & 63, wr = wid >> 2, wc = wid & 3, fr = lane & 15, fq = lane >> 4;
    const int ntf = g.K / BK;
    unsigned voffA[2], voffB[2];
#pragma unroll
    for (int i = 0; i < 2; ++i) { int R, C; stage_rc(tid * 16 + i * 8192, R, C); const int Rb = Epi::PERM ? ((R & ~31) + perm32(R & 31)) : R;
        voffA[i] = (unsigned)(R * g.lda + C) * 2u; voffB[i] = (unsigned)(Rb * g.ldb + C) * 2u; }
    const size_t kstep = (size_t)(BK * 2);
    const size_t hstepA = (size_t)HALF * g.lda * 2, hstepB = (size_t)HALF * g.ldb * 2;
    const size_t tstepA = 2 * hstepA, tstepB = 2 * hstepB;
    const unsigned ldsw = (unsigned)wid * 1024u;
    const int aoff = lds_byte(wr * 64 + fr, fq * 8), boff = lds_byte(wc * 32 + fr, fq * 8);
#define PG8_SA(b, h) (((b) * 2 + (h)) * HTB)
#define PG8_SB(b, h) ((4 + (b) * 2 + (h)) * HTB)
#define PG8_STAGE(bufoff, gbase, voff) do { _Pragma("unroll") for (int _i = 0; _i < 2; ++_i) \
        __builtin_amdgcn_global_load_lds((const unsigned*)((const char*)(gbase) + (voff)[_i]), (LAS unsigned*)(lds + (bufoff) + ldsw + _i * 8192), 16, 0, 0); } while (0)
#define PG8_LDA(dst, b, h) do { _Pragma("unroll") for (int m = 0; m < 4; ++m) _Pragma("unroll") for (int k = 0; k < 2; ++k) dst[m][k] = *(const LAS bf16x8*)(lds + PG8_SA(b, h) + aoff + m * 2048 + k * 1024); } while (0)
#define PG8_LDB(dst, b, h) do { _Pragma("unroll") for (int n = 0; n < 2; ++n) _Pragma("unroll") for (int k = 0; k < 2; ++k) dst[n][k] = *(const LAS bf16x8*)(lds + PG8_SB(b, h) + boff + n * 2048 + k * 1024); } while (0)
#define PG8_MMA(ai, bj, At, Bt) do { __builtin_amdgcn_s_setprio(1); _Pragma("unroll") for (int m = 0; m < 4; ++m) _Pragma("unroll") for (int n = 0; n < 2; ++n) _Pragma("unroll") for (int k = 0; k < 2; ++k) \
        acc[ai][bj][m][n] = __builtin_amdgcn_mfma_f32_16x16x32_bf16(Bt[n][k], At[m][k], acc[ai][bj][m][n], 0, 0, 0); __builtin_amdgcn_s_setprio(0); } while (0)
#define PG8_WAIT_V(n) asm volatile("s_waitcnt vmcnt(" #n ")" ::: "memory")
#define PG8_WAIT_L(n) asm volatile("s_waitcnt lgkmcnt(" #n ")" ::: "memory")
#define PG8_BAR __builtin_amdgcn_s_barrier()
#define PG8_SCHED __builtin_amdgcn_sched_barrier(0)
    Unit cur{0, 0, 0, 0, 0}, nxt{0, 0, 0, 0, 0}; int ui = 0;
    if (!S.next(0, cur)) return;
    f32x4 acc[2][2][4][2];
#pragma unroll
    for (int a = 0; a < 2; ++a)
#pragma unroll
        for (int b = 0; b < 2; ++b)
#pragma unroll
            for (int m = 0; m < 4; ++m)
#pragma unroll
                for (int n = 0; n < 2; ++n) acc[a][b][m][n] = (f32x4){0.f, 0.f, 0.f, 0.f};
    bf16x8 At[4][2], B0[2][2], B1[2][2];
    const char* cA = (const char*)g.A + ((size_t)cur.z * g.zA + (VARK ? cur.kb : 0)) * 2 + (size_t)cur.pm * tstepA; const char* cB = (const char*)g.Bt + ((size_t)cur.z * g.zB + (VARK ? cur.kb : 0)) * 2 + (size_t)cur.pn * tstepB;
    if constexpr (SP2) {
        PG8_STAGE(PG8_SB(0, 0), cB, voffB); PG8_STAGE(PG8_SB(0, 1), cB + hstepB, voffB); PG8_STAGE(PG8_SA(0, 0), cA, voffA); PG8_STAGE(PG8_SA(0, 1), cA + hstepA, voffA);
        if (wr == 1) PG8_BAR;
        PG8_WAIT_V(2); PG8_BAR;
        PG8_STAGE(PG8_SB(1, 0), cB + kstep, voffB); PG8_STAGE(PG8_SA(1, 0), cA + kstep, voffA); PG8_STAGE(PG8_SB(1, 1), cB + hstepB + kstep, voffB);
        PG8_WAIT_V(6); PG8_BAR;
    } else {
        PG8_STAGE(PG8_SB(0, 0), cB, voffB); PG8_STAGE(PG8_SA(0, 0), cA, voffA); PG8_STAGE(PG8_SB(0, 1), cB + hstepB, voffB); PG8_STAGE(PG8_SA(0, 1), cA + hstepA, voffA);
        if (wr == 1) PG8_BAR;
        PG8_WAIT_V(4); PG8_BAR;
        PG8_STAGE(PG8_SB(1, 0), cB + kstep, voffB); PG8_STAGE(PG8_SA(1, 0), cA + kstep, voffA); PG8_STAGE(PG8_SB(1, 1), cB + hstepB + kstep, voffB);
        PG8_WAIT_V(6); PG8_BAR;
    }
#pragma unroll 1
    for (;;) {
        const bool has_next = S.next(ui + 1, nxt);
        const char* nA = has_next ? (const char*)g.A + ((size_t)nxt.z * g.zA + (VARK ? nxt.kb : 0)) * 2 + (size_t)nxt.pm * tstepA : cA;
        const char* nB = has_next ? (const char*)g.Bt + ((size_t)nxt.z * g.zB + (VARK ? nxt.kb : 0)) * 2 + (size_t)nxt.pn * tstepB : cB;
        const int nt = (VARK && cur.nt) ? cur.nt : ntf;
#pragma unroll 1
        for (int t = 0; t < nt; t += 2) {
            const bool last = (t == nt - 2);
            const char* a1 = cA + (size_t)(t + 1) * kstep;
            const char* a2 = last ? nA : cA + (size_t)(t + 2) * kstep; const char* b2 = last ? nB : cB + (size_t)(t + 2) * kstep;
            const char* a3 = a2 + kstep; const char* b3 = b2 + kstep;
            if constexpr (SP2) {
            PG8_LDB(B0, 0, 0); PG8_LDB(B1, 0, 1); PG8_SCHED; PG8_LDA(At, 0, 0); PG8_STAGE(PG8_SA(1, 1), a1 + hstepA, voffA);
            PG8_WAIT_V(8); PG8_WAIT_L(0); PG8_BAR; PG8_MMA(0, 0, At, B0); PG8_MMA(0, 1, At, B1); PG8_BAR; PG8_SCHED;
            PG8_LDA(At, 0, 1); PG8_STAGE(PG8_SB(0, 0), b2, voffB); PG8_STAGE(PG8_SB(0, 1), b2 + hstepB, voffB); PG8_STAGE(PG8_SA(0, 0), a2, voffA);
            PG8_WAIT_V(8); PG8_WAIT_L(0); PG8_BAR; PG8_MMA(1, 0, At, B0); PG8_MMA(1, 1, At, B1); PG8_BAR; PG8_SCHED;
            PG8_LDB(B0, 1, 0); PG8_LDB(B1, 1, 1); PG8_SCHED; PG8_LDA(At, 1, 0); PG8_STAGE(PG8_SA(0, 1), a2 + hstepA, voffA);
            PG8_WAIT_V(8); PG8_WAIT_L(0); PG8_BAR; PG8_MMA(0, 0, At, B0); PG8_MMA(0, 1, At, B1); PG8_BAR; PG8_SCHED;
            PG8_LDA(At, 1, 1); PG8_STAGE(PG8_SB(1, 0), b3, voffB); PG8_STAGE(PG8_SB(1, 1), b3 + hstepB, voffB); PG8_STAGE(PG8_SA(1, 0), a3, voffA);
            PG8_WAIT_V(8); PG8_WAIT_L(0); PG8_BAR; PG8_MMA(1, 0, At, B0); PG8_MMA(1, 1, At, B1); PG8_BAR; PG8_SCHED;
            } else {
            PG8_LDB(B0, 0, 0); PG8_SCHED; PG8_LDA(At, 0, 0); PG8_STAGE(PG8_SA(1, 1), a1 + hstepA, voffA);
            PG8_WAIT_L(8); PG8_BAR; PG8_WAIT_L(0); PG8_MMA(0, 0, At, B0); PG8_BAR; PG8_SCHED;
            PG8_LDB(B1, 0, 1); PG8_STAGE(PG8_SB(0, 0), b2, voffB);
            PG8_BAR; PG8_WAIT_L(0); PG8_MMA(0, 1, At, B1); PG8_BAR;
            PG8_LDA(At, 0, 1); PG8_STAGE(PG8_SA(0, 0), a2, voffA);
            PG8_BAR; PG8_WAIT_L(0); PG8_MMA(1, 0, At, B0); PG8_BAR; PG8_SCHED;
            PG8_STAGE(PG8_SB(0, 1), b2 + hstepB, voffB);
            PG8_WAIT_V(6); PG8_BAR; PG8_MMA(1, 1, At, B1); PG8_BAR;
            PG8_LDB(B0, 1, 0); PG8_SCHED; PG8_LDA(At, 1, 0); PG8_STAGE(PG8_SA(0, 1), a2 + hstepA, voffA);
            PG8_WAIT_L(8); PG8_BAR; PG8_WAIT_L(0); PG8_MMA(0, 0, At, B0); PG8_BAR; PG8_SCHED;
            PG8_LDB(B1, 1, 1); PG8_STAGE(PG8_SB(1, 0), b3, voffB);
            PG8_BAR; PG8_WAIT_L(0); PG8_MMA(0, 1, At, B1); PG8_BAR;
            PG8_LDA(At, 1, 1); PG8_STAGE(PG8_SA(1, 0), a3, voffA);
            PG8_BAR; PG8_WAIT_L(0); PG8_MMA(1, 0, At, B0); PG8_BAR; PG8_SCHED;
            PG8_STAGE(PG8_SB(1, 1), b3 + hstepB, voffB);
            PG8_WAIT_V(6); PG8_BAR; PG8_MMA(1, 1, At, B1); PG8_BAR;
            }
        }
        if constexpr (ALIGN_EPI) { if (wr == 0) PG8_BAR; }
        E(acc, cur, wr, wc, fr, fq);
        if (!has_next) break;
        if (!E.keep(cur)) {
#pragma unroll
        for (int a = 0; a < 2; ++a)
#pragma unroll
            for (int b = 0; b < 2; ++b)
#pragma unroll
                for (int m = 0; m < 4; ++m)
#pragma unroll
                    for (int n = 0; n < 2; ++n) acc[a][b][m][n] = (f32x4){0.f, 0.f, 0.f, 0.f};
        }
        cur.pm = nxt.pm; cur.pn = nxt.pn; cur.z = nxt.z; cur.kb = nxt.kb; cur.nt = nxt.nt; cA = nA; cB = nB; ++ui;
        if constexpr (ALIGN_EPI) { if (wr == 1) PG8_BAR; }
    }
    PG8_WAIT_V(0);
    if constexpr (!ALIGN_EPI) { if (wr == 0) PG8_BAR; }
    PG8_BAR;
#undef PG8_SA
#undef PG8_SB
#undef PG8_STAGE
#undef PG8_LDA
#undef PG8_LDB
#undef PG8_MMA
#undef PG8_WAIT_V
#undef PG8_WAIT_L
#undef PG8_BAR
#undef PG8_SCHED
}

typedef f32x4 Acc[2][2][4][2];

struct EpiBf16 {
    static constexpr bool PERM = true;
    bf16_t* O; int ldc; size_t zO; int row_off; const float* bias; int sig_pn0;
    __device__ __forceinline__ bool keep(const Unit&) const { return false; }
    __device__ __forceinline__ void operator()(Acc& acc, const Unit& u, int wr, int wc, int fr, int fq) const {
        const int row0 = row_off + u.pm * BM + wr * 64 + fr, col0 = u.pn * BM + wc * 32 + 8 * fq;
        bf16_t* base = O + (size_t)u.z * zO;
        const bool sig = u.pn >= sig_pn0;
        f32x4 bv[2][2];
#pragma unroll
        for (int bj = 0; bj < 2; ++bj)
#pragma unroll
            for (int n = 0; n < 2; ++n) bv[bj][n] = sig ? *(const f32x4*)(bias + (col0 - sig_pn0 * BM) + bj * HALF + 4 * n) : (f32x4){0.f, 0.f, 0.f, 0.f};
#pragma unroll
        for (int ai = 0; ai < 2; ++ai)
#pragma unroll
            for (int m = 0; m < 4; ++m) { bf16_t* rowp = base + (size_t)(row0 + ai * HALF + m * 16) * ldc + col0;
#pragma unroll
                for (int bj = 0; bj < 2; ++bj) { f32x4 v0 = acc[ai][bj][m][0], v1 = acc[ai][bj][m][1];
                    if (sig) { v0 += bv[bj][0]; v1 += bv[bj][1];
#pragma unroll
                        for (int j = 0; j < 4; ++j) { v0[j] = sigmoidf_(v0[j]); v1[j] = sigmoidf_(v1[j]); } }
                    u32x4 w; w.x = cvt_pk_bf16(v0[0], v0[1]); w.y = cvt_pk_bf16(v0[2], v0[3]); w.z = cvt_pk_bf16(v1[0], v1[1]); w.w = cvt_pk_bf16(v1[2], v1[3]);
                    *(u32x4*)(rowp + bj * HALF) = w; } }
    }
};
struct EpiF1 {
    static constexpr bool PERM = true;
    bf16_t* YT; bf16_t* YTC;
    __device__ __forceinline__ bool keep(const Unit&) const { return false; }
    __device__ __forceinline__ void operator()(Acc& acc, const Unit& u, int wr, int wc, int fr, int fq) const {
        const int b = u.pn / 17, pt = u.pn - b * 17;
        const int cp0 = wr * 64 + fr, tk0 = wc * 32 + 8 * fq;
        bf16_t* base; int ld;
        if (pt == 0) { base = YTC + ((size_t)(b * 8 + u.z) * 256) * 512 + u.pm * 256; ld = 512; }
        else { base = YT + ((size_t)(b * 8 + u.z) * 256) * 8192 + u.pm * 4096 + (pt - 1) * 256; ld = 8192; }
#pragma unroll
        for (int ai = 0; ai < 2; ++ai)
#pragma unroll
            for (int m = 0; m < 4; ++m) { bf16_t* rowp = base + (size_t)(cp0 + ai * HALF + m * 16) * ld + tk0;
#pragma unroll
                for (int bj = 0; bj < 2; ++bj) { const f32x4 v0 = acc[ai][bj][m][0], v1 = acc[ai][bj][m][1];
                    u32x4 w; w.x = cvt_pk_bf16(v0[0], v0[1]); w.y = cvt_pk_bf16(v0[2], v0[3]); w.z = cvt_pk_bf16(v1[0], v1[1]); w.w = cvt_pk_bf16(v1[2], v1[3]);
                    *(u32x4*)(rowp + bj * HALF) = w; } }
    }
};
struct EpiBranch {
    static constexpr bool PERM = true;
    const bf16_t* G; bf16_t* O;
    __device__ __forceinline__ bool keep(const Unit& u) const { return u.z < 2; }
    __device__ __forceinline__ void operator()(Acc& acc, const Unit& u, int wr, int wc, int fr, int fq) const {
        const int row0 = u.pm * BM + wr * 64 + fr, col0 = u.pn * BM + wc * 32 + 8 * fq;
#pragma unroll
        for (int ai = 0; ai < 2; ++ai)
#pragma unroll
            for (int m = 0; m < 4; ++m) { const size_t row = (size_t)(row0 + ai * HALF + m * 16);
#pragma unroll
                for (int bj = 0; bj < 2; ++bj) {
                    const u32x4 ga = *(const u32x4*)(G + row * N1 + u.z * DM + col0 + bj * HALF);
                    float s[8] = {bflo(ga.x), bfhi(ga.x), bflo(ga.y), bfhi(ga.y), bflo(ga.z), bfhi(ga.z), bflo(ga.w), bfhi(ga.w)};
                    if (u.z < 2) { const u32x4 gb = *(const u32x4*)(G + row * N1 + (u.z + 1) * DM + col0 + bj * HALF);
                        const float d[8] = {bflo(gb.x), bfhi(gb.x), bflo(gb.y), bfhi(gb.y), bflo(gb.z), bfhi(gb.z), bflo(gb.w), bfhi(gb.w)};
#pragma unroll
                        for (int j = 0; j < 8; ++j) s[j] = fmaxf(s[j], 1e-20f) * __builtin_amdgcn_rcpf(fmaxf(d[j], 1e-20f)); }
                    else {
#pragma unroll
                        for (int j = 0; j < 8; ++j) s[j] = fmaxf(s[j], 1e-20f); }
                    f32x4 v0 = acc[ai][bj][m][0], v1 = acc[ai][bj][m][1];
#pragma unroll
                    for (int j = 0; j < 4; ++j) { v0[j] *= s[j]; v1[j] *= s[4 + j]; }
                    acc[ai][bj][m][0] = v0; acc[ai][bj][m][1] = v1;
                    if (u.z == 2) { u32x4 w; w.x = cvt_pk_bf16(v0[0], v0[1]); w.y = cvt_pk_bf16(v0[2], v0[3]); w.z = cvt_pk_bf16(v1[0], v1[1]); w.w = cvt_pk_bf16(v1[2], v1[3]);
                        *(u32x4*)(O + row * DM + col0 + bj * HALF) = w; } } }
    }
};
struct EpiResid {
    static constexpr bool PERM = false;
    const float* X; float* Y; const float* gate; float* YP; const float* xin_l; const float* xin_c;
    __device__ __forceinline__ bool keep(const Unit&) const { return false; }
    __device__ __forceinline__ void operator()(Acc& acc, const Unit& u, int wr, int wc, int fr, int fq) const {
        const int row0 = u.pm * BM + wr * 64 + fr, col0 = u.pn * BM + wc * 32 + 4 * fq;
        if (u.nt) {
            float* yp = YP + ((size_t)u.z * 512 + (u.pm / 17) * 256 + wr * 64 + fr) * DM + col0;
#pragma unroll
            for (int ai = 0; ai < 2; ++ai)
#pragma unroll
                for (int m = 0; m < 4; ++m)
#pragma unroll
                    for (int bj = 0; bj < 2; ++bj)
#pragma unroll
                        for (int n = 0; n < 2; ++n) *(f32x4*)(yp + (size_t)(ai * HALF + m * 16) * DM + bj * HALF + n * 16) = acc[ai][bj][m][n];
            return; }
        const int b = u.pm / 17, pt = u.pm - b * 17, j = (pt == 0) ? 2 : b;
        const float* xb = xin_l ? (pt == 0 ? xin_c + (size_t)(b * CTX) * DM : xin_l + (size_t)(b * SEQ + (pt - 1) * 256) * DM) : X + (size_t)u.pm * BM * DM;
        const float* gv = gate + (size_t)j * NADA + col0;
        f32x4 gt[2][2];
#pragma unroll
        for (int bj = 0; bj < 2; ++bj)
#pragma unroll
            for (int n = 0; n < 2; ++n) gt[bj][n] = *(const f32x4*)(gv + bj * HALF + n * 16);
#pragma unroll
        for (int ai = 0; ai < 2; ++ai)
#pragma unroll
            for (int m = 0; m < 4; ++m) { const size_t off = (size_t)(row0 + ai * HALF + m * 16) * DM + col0, xoff = (size_t)(wr * 64 + fr + ai * HALF + m * 16) * DM + col0;
#pragma unroll
                for (int bj = 0; bj < 2; ++bj)
#pragma unroll
                    for (int n = 0; n < 2; ++n) { const f32x4 xv = *(const f32x4*)(xb + xoff + bj * HALF + n * 16);
                        *(f32x4*)(Y + off + bj * HALF + n * 16) = xv * DN_ALPHA + gt[bj][n] * acc[ai][bj][m][n]; }
                asm volatile("" ::: "memory"); }
    }
};
struct EpiProj {
    static constexpr bool PERM = true;
    bf16_t* O; const float* bias; const float* qkg; const float* rope; LAS float* EX; bf16_t* KV;
    __device__ __forceinline__ bool keep(const Unit&) const { return false; }
    __device__ __forceinline__ void operator()(Acc& acc, const Unit& u, int wr, int wc, int fr, int fq) const {
        const int row0 = u.pm * BM + wr * 64 + fr, col0 = u.pn * BM + wc * 32 + 8 * fq;
        const int pt = u.pm % 17; const bool lat = pt != 0;
        const int kind = (u.pn < 16) ? 1 : ((u.pn >= 32 && u.pn < 42) ? 2 : ((u.pn >= 44) ? 3 : 0));
        const int i0 = 16 * wc + 4 * fq;
        if (kind == 2) {
#pragma unroll
            for (int ai = 0; ai < 2; ++ai)
#pragma unroll
                for (int m = 0; m < 4; ++m)
#pragma unroll
                    for (int bj = 0; bj < 2; ++bj) { const f32x4 v0 = acc[ai][bj][m][0], v1 = acc[ai][bj][m][1];
                        float ss = (v0[0] * v0[0] + v0[1] * v0[1]) + (v0[2] * v0[2] + v0[3] * v0[3]) + (v1[0] * v1[0] + v1[1] * v1[1]) + (v1[2] * v1[2] + v1[3] * v1[3]);
                        ss += __shfl_xor(ss, 16); ss += __shfl_xor(ss, 32);
                        if (fq == 0) EX[((ai * HALF + wr * 64 + m * 16 + fr) * 2 + bj) * 4 + wc] = ss; }
            asm volatile("s_waitcnt lgkmcnt(0)" ::: "memory"); __builtin_amdgcn_s_barrier(); asm volatile("" ::: "memory");
            const float* gg = qkg + (u.pn >= 40 ? 128 : 0);
            const f32x4 gA = *(const f32x4*)(gg + i0), gB = *(const f32x4*)(gg + 64 + i0);
#pragma unroll
            for (int ai = 0; ai < 2; ++ai)
#pragma unroll
                for (int m = 0; m < 4; ++m)
#pragma unroll
                    for (int bj = 0; bj < 2; ++bj) { const f32x4 p = *(const LAS f32x4*)(EX + ((ai * HALF + wr * 64 + m * 16 + fr) * 2 + bj) * 4);
                        const float r = 1.0f / sqrtf(((p[0] + p[1]) + (p[2] + p[3])) * (1.0f / 128.0f) + NORM_EPS);
                        f32x4 v0 = acc[ai][bj][m][0], v1 = acc[ai][bj][m][1];
                        v0[0] *= r * gA[0]; v0[1] *= r * gB[0]; v0[2] *= r * gA[1]; v0[3] *= r * gB[1];
                        v1[0] *= r * gA[2]; v1[1] *= r * gB[2]; v1[2] *= r * gA[3]; v1[3] *= r * gB[3];
                        acc[ai][bj][m][0] = v0; acc[ai][bj][m][1] = v1; }
        }
        const bool sig = kind == 3;
        f32x4 bv[2][2];
#pragma unroll
        for (int bj = 0; bj < 2; ++bj)
#pragma unroll
            for (int n = 0; n < 2; ++n) bv[bj][n] = sig ? *(const f32x4*)(bias + (col0 - DIN) + bj * HALF + 4 * n) : (f32x4){0.f, 0.f, 0.f, 0.f};
        const bool dorope = lat && (kind == 1 || kind == 2);
        const int t0 = (pt - 1) * 256 + wr * 64 + fr;
        const bool iskv = (u.pn >= 8 && u.pn < 24) || (u.pn >= 40 && u.pn < 44);
        const int slot0 = (u.pn < 24) ? (u.pn - 8) * 2 : 32 + (u.pn - 40) * 2;
        bf16_t* kvb = KV + (((size_t)((u.pm / 17) * 40 + slot0)) * LT + pt * 256 + wr * 64 + fr) * 128 + wc * 32 + 8 * fq;
#pragma unroll
        for (int ai = 0; ai < 2; ++ai)
#pragma unroll
            for (int m = 0; m < 4; ++m) { bf16_t* rowp = O + (size_t)(row0 + ai * HALF + m * 16) * N1 + col0;
                f32x4 cs0 = {1.f, 0.f, 1.f, 0.f}, cs1 = cs0;
                if (dorope) { const float* rp = rope + ((size_t)(t0 + ai * HALF + m * 16) * 64 + i0) * 2; cs0 = *(const f32x4*)rp; cs1 = *(const f32x4*)(rp + 4); }
#pragma unroll
                for (int bj = 0; bj < 2; ++bj) { f32x4 v0 = acc[ai][bj][m][0], v1 = acc[ai][bj][m][1];
                    if (sig) { v0 += bv[bj][0]; v1 += bv[bj][1];
#pragma unroll
                        for (int j = 0; j < 4; ++j) { v0[j] = sigmoidf_(v0[j]); v1[j] = sigmoidf_(v1[j]); } }
                    if (dorope) {
                        const f32x4 a = v0, b = v1;
                        v0[0] = a[0] * cs0[0] - a[1] * cs0[1]; v0[1] = a[1] * cs0[0] + a[0] * cs0[1]; v0[2] = a[2] * cs0[2] - a[3] * cs0[3]; v0[3] = a[3] * cs0[2] + a[2] * cs0[3];
                        v1[0] = b[0] * cs1[0] - b[1] * cs1[1]; v1[1] = b[1] * cs1[0] + b[0] * cs1[1]; v1[2] = b[2] * cs1[2] - b[3] * cs1[3]; v1[3] = b[3] * cs1[2] + b[2] * cs1[3]; }
                    u32x4 w; w.x = cvt_pk_bf16(v0[0], v0[1]); w.y = cvt_pk_bf16(v0[2], v0[3]); w.z = cvt_pk_bf16(v1[0], v1[1]); w.w = cvt_pk_bf16(v1[2], v1[3]);
                    if (iskv) *(u32x4*)(kvb + (size_t)bj * LT * 128 + (size_t)(ai * HALF + m * 16) * 128) = w;
                    else *(u32x4*)(rowp + bj * HALF) = w; } }
    }
};
struct EpiConv {
    static constexpr bool PERM = true;
    bf16_t* U2; const float* cw; const float* cb; float* AE; float* CP; float* GP; LAS float* EX;
    __device__ __forceinline__ bool keep(const Unit&) const { return false; }
    __device__ __forceinline__ void operator()(Acc& acc, const Unit& u, int wr, int wc, int fr, int fq) const {
        const int lane = fr + 16 * fq;
#pragma unroll
        for (int ai = 0; ai < 2; ++ai) { const int q = 2 * ai + wr;
            if (fr == 0) { *(LAS f32x4*)(EX + ((q * 2 + 0) * 4 + wc) * 32 + 8 * fq) = acc[ai][0][0][0]; *(LAS f32x4*)(EX + ((q * 2 + 0) * 4 + wc) * 32 + 8 * fq + 4) = acc[ai][0][0][1]; }
            if (fr == 15) { *(LAS f32x4*)(EX + ((q * 2 + 1) * 4 + wc) * 32 + 8 * fq) = acc[ai][0][3][0]; *(LAS f32x4*)(EX + ((q * 2 + 1) * 4 + wc) * 32 + 8 * fq + 4) = acc[ai][0][3][1]; } }
        asm volatile("s_waitcnt lgkmcnt(0)" ::: "memory"); __builtin_amdgcn_s_barrier(); asm volatile("" ::: "memory");
        const int f0 = u.pn * 128 + wc * 32 + 8 * fq;
        const int row0 = u.pm * BM + wr * 64 + fr;
#pragma unroll
        for (int n = 0; n < 2; ++n) {
            const f32x4 w0 = *(const f32x4*)(cw + f0 + 4 * n), w1 = *(const f32x4*)(cw + DFF + f0 + 4 * n), w2 = *(const f32x4*)(cw + 2 * DFF + f0 + 4 * n), bv = *(const f32x4*)(cb + f0 + 4 * n);
#pragma unroll
            for (int ai = 0; ai < 2; ++ai) { const int q = 2 * ai + wr;
                f32x4 hup = {0.f, 0.f, 0.f, 0.f}, hdn = hup;
                if (q > 0) hup = *(const LAS f32x4*)(EX + (((q - 1) * 2 + 1) * 4 + wc) * 32 + 8 * fq + 4 * n);
                if (q < 3) hdn = *(const LAS f32x4*)(EX + (((q + 1) * 2 + 0) * 4 + wc) * 32 + 8 * fq + 4 * n);
#pragma unroll
                for (int m = 0; m < 4; ++m) {
                    const f32x4 a = acc[ai][0][m][n], g = acc[ai][1][m][n];
                    f32x4 c;
#pragma unroll
                    for (int j = 0; j < 4; ++j) {
                        const float t1 = __shfl(a[j], lane - 1), t2 = (m > 0) ? __shfl(acc[ai][0][m > 0 ? m - 1 : 0][n][j], lane + 15) : hup[j];
                        const float d1 = __shfl(a[j], lane + 1), d2 = (m < 3) ? __shfl(acc[ai][0][m < 3 ? m + 1 : 3][n][j], lane - 15) : hdn[j];
                        const float up = (fr == 0) ? t2 : t1, dn = (fr == 15) ? d2 : d1;
                        c[j] = w0[j] * up + w1[j] * a[j] + w2[j] * dn + bv[j]; }
                    const f32x2 g0 = gelu_pk((f32x2){c[0], c[1]}), g1 = gelu_pk((f32x2){c[2], c[3]});
                    u32x2 w; w.x = cvt_pk_bf16(g0.x * g[0], g0.y * g[1]); w.y = cvt_pk_bf16(g1.x * g[2], g1.y * g[3]);
                    *(u32x2*)(U2 + (size_t)(row0 + ai * HALF + m * 16) * DFF + f0 + 4 * n) = w;
                    if ((q == 0 && m == 0 && fr == 0) || (q == 3 && m == 3 && fr == 15)) { const size_t eo = ((size_t)(u.pm * 2 + (q == 3 ? 1 : 0))) * DFF + f0 + 4 * n;
                        *(f32x4*)(AE + eo) = a; *(f32x4*)(CP + eo) = c; *(f32x4*)(GP + eo) = g; }
                }
            }
        }
    }
};
struct OrdZ { int G, c, n, shift;
    __device__ __forceinline__ bool next(int i, Unit& u) const { u.kb = 0; u.nt = 0; const int L = i * G + c; if (L >= n) return false; const int q = n / 8, xcd = L % 8, off = L / 8, w = xcd * q + off; u.z = w >> shift; u.pm = w & ((1 << shift) - 1); u.pn = 0; return true; } };
struct EpiF2 {
    static constexpr bool PERM = true;
    bf16_t* O; int roff, fold;
    __device__ __forceinline__ bool keep(const Unit&) const { return false; }
    __device__ __forceinline__ void operator()(Acc& acc, const Unit& u, int wr, int wc, int fr, int fq) const {
        const int b = u.z >> 3, gq = u.z & 7;
        bf16_t* base = O + (size_t)(b * LT + roff) * BW + gq * 256 + wc * 32 + 8 * fq; const int r0 = u.pm * 256 + wr * 64 + fr;
#pragma unroll
        for (int ai = 0; ai < 2; ++ai)
#pragma unroll
            for (int m = 0; m < 4; ++m) { int r = r0 + ai * 128 + m * 16; if (fold && r > 2048) r = 6144 - r;
#pragma unroll
                for (int bj = 0; bj < 2; ++bj) { const f32x4 v0 = acc[ai][bj][m][0], v1 = acc[ai][bj][m][1];
                    u32x4 w; w.x = cvt_pk_bf16(v0[0], v0[1]); w.y = cvt_pk_bf16(v0[2], v0[3]); w.z = cvt_pk_bf16(v1[0], v1[1]); w.w = cvt_pk_bf16(v1[2], v1[3]);
                    *(u32x4*)(base + (size_t)r * BW + bj * 128) = w; } }
    }
};
}

namespace att {
constexpr int D = 128, NW = 8, QBLK = 32, KVBLK = 64;
constexpr float SCALE = 0.088388347648318440f;
constexpr float THR = 8.f;
constexpr int LDQ = N1, LDK = 128, LDO = BW;
constexpr size_t SHM_V = KVBLK * D * 2, SHM_K = KVBLK * D * 2, SHM_ATTN = 2 * SHM_V + 2 * SHM_K + NW * 64 * 4;
#define KSWZ(row, colB) ((row) * 256 + ((colB) ^ (((row) & 7) << 4)))
#define SBAR() __builtin_amdgcn_sched_barrier(0)
__device__ __forceinline__ int crow(int r, int hi) { return (r & 3) + 8 * (r >> 2) + 4 * hi; }
__device__ __forceinline__ unsigned cvtpk(float lo, float hi) { unsigned r; asm volatile("v_cvt_pk_bf16_f32 %0, %1, %2" : "=v"(r) : "v"(lo), "v"(hi)); return r; }
__device__ __forceinline__ void partialSM(f32x16& p0, f32x16& p1, float& m_reg, float& mn, float& alpha) {
  constexpr float C = SCALE * 1.4426950408889634f;
  float pmax = p0[0];
#pragma unroll
  for (int r = 1; r < 16; ++r) pmax = fmaxf(pmax, p0[r]);
#pragma unroll
  for (int r = 0; r < 16; ++r) pmax = fmaxf(pmax, p1[r]);
  { auto rr = __builtin_amdgcn_permlane32_swap(__float_as_uint(pmax), __float_as_uint(pmax), false, false);
    pmax = fmaxf(__uint_as_float(rr[0]), __uint_as_float(rr[1])); }
  if (__builtin_expect(__all(pmax - m_reg <= THR / SCALE), 1)) { mn = m_reg; alpha = 1.f; }
  else { mn = fmaxf(m_reg, pmax); alpha = __builtin_amdgcn_exp2f((m_reg - mn) * C); m_reg = mn; }
  float mnC = -mn * C;
#pragma unroll
  for (int r = 0; r < 16; ++r) p0[r] = fmaf(p0[r], C, mnC);
#pragma unroll
  for (int r = 0; r < 16; ++r) p1[r] = fmaf(p1[r], C, mnC);
#pragma unroll
  for (int r = 0; r < 16; ++r) p0[r] = __builtin_amdgcn_exp2f(p0[r]);
}
__device__ __forceinline__ void finishSM(f32x16& p0, f32x16& p1, float alpha, float& l_reg, bf16x8& pa0, bf16x8& pa1, bf16x8& pa2, bf16x8& pa3) {
#pragma unroll
  for (int r = 0; r < 16; ++r) p1[r] = __builtin_amdgcn_exp2f(p1[r]);
  float ps = 0;
#pragma unroll
  for (int r = 0; r < 16; ++r) ps += p0[r];
#pragma unroll
  for (int r = 0; r < 16; ++r) ps += p1[r];
  { auto rr = __builtin_amdgcn_permlane32_swap(__float_as_uint(ps), __float_as_uint(ps), false, false);
    ps = __uint_as_float(rr[0]) + __uint_as_float(rr[1]); }
  l_reg = l_reg * alpha + ps;
#define PK4(P, BASE, OUT) do { unsigned a0 = cvtpk(P[BASE + 0], P[BASE + 1]), a1 = cvtpk(P[BASE + 2], P[BASE + 3]);   \
    unsigned b0 = cvtpk(P[BASE + 4], P[BASE + 5]), b1 = cvtpk(P[BASE + 6], P[BASE + 7]);                              \
    auto r0 = __builtin_amdgcn_permlane32_swap(a0, b0, false, false); auto r1 = __builtin_amdgcn_permlane32_swap(a1, b1, false, false); \
    u32x4 w = {r0[0], r1[0], r0[1], r1[1]}; OUT = *reinterpret_cast<bf16x8*>(&w); } while (0)
  PK4(p0, 0, pa0); PK4(p0, 8, pa1); PK4(p1, 0, pa2); PK4(p1, 8, pa3);
#undef PK4
}
__device__ __forceinline__ void qkt(f32x16& p0, f32x16& p1, const bf16_t* Ks, const bf16x8* qr, int r32, int hi) {
  p0 = f32x16{}; p1 = f32x16{};
#pragma unroll
  for (int d0 = 0; d0 < 8; ++d0) { int cb = (d0 * 16 + hi * 8) * 2;
    bf16x8 b0 = *reinterpret_cast<const bf16x8*>((const char*)Ks + KSWZ(r32, cb));
    bf16x8 b1 = *reinterpret_cast<const bf16x8*>((const char*)Ks + KSWZ(32 + r32, cb));
    p0 = __builtin_amdgcn_mfma_f32_32x32x16_bf16(b0, qr[d0], p0, 0, 0, 0);
    p1 = __builtin_amdgcn_mfma_f32_32x32x16_bf16(b1, qr[d0], p1, 0, 0, 0); }
}
__device__ __forceinline__ int v_st(int k, int c) { const int kk = (k & ~0xC) | ((k & 4) << 1) | ((k & 8) >> 1); return ((kk >> 3) * 4 + (c >> 5)) * 512 + ((kk & 7) * 32 + (c & 31)) * 2; }
__device__ __forceinline__ int v_rd_base(int lane) { return ((lane & 3) << 3) | (((lane >> 2) & 3) << 6) | (((lane >> 4) & 1) << 5) | (((lane >> 5) & 1) << 8); }
constexpr int v_rd_off(int d0, int ks, int half) { return d0 * 512 + ks * 4096 + half * 2048; }
template <int OFF> __device__ __forceinline__ s16x4 tr_read(int vb) {
  s16x4 r; asm volatile("ds_read_b64_tr_b16 %0, %1 offset:%2" : "=&v"(r) : "v"(vb), "i"(OFF) : "memory"); return r;
}
template <int D0> __device__ __forceinline__ void pv_one(f32x16& od, int vb, bf16x8 pa0, bf16x8 pa1, bf16x8 pa2, bf16x8 pa3) {
  const s16x4 l0 = tr_read<v_rd_off(D0, 0, 0)>(vb), h0 = tr_read<v_rd_off(D0, 0, 1)>(vb), l1 = tr_read<v_rd_off(D0, 1, 0)>(vb), h1 = tr_read<v_rd_off(D0, 1, 1)>(vb);
  const s16x4 l2 = tr_read<v_rd_off(D0, 2, 0)>(vb), h2 = tr_read<v_rd_off(D0, 2, 1)>(vb), l3 = tr_read<v_rd_off(D0, 3, 0)>(vb), h3 = tr_read<v_rd_off(D0, 3, 1)>(vb);
  asm volatile("s_waitcnt lgkmcnt(0)" ::: "memory"); SBAR();
#define PK(L, H) (bf16x8){L[0], L[1], L[2], L[3], H[0], H[1], H[2], H[3]}
  od = __builtin_amdgcn_mfma_f32_32x32x16_bf16(pa0, PK(l0, h0), od, 0, 0, 0);
  od = __builtin_amdgcn_mfma_f32_32x32x16_bf16(pa1, PK(l1, h1), od, 0, 0, 0);
  od = __builtin_amdgcn_mfma_f32_32x32x16_bf16(pa2, PK(l2, h2), od, 0, 0, 0);
  od = __builtin_amdgcn_mfma_f32_32x32x16_bf16(pa3, PK(l3, h3), od, 0, 0, 0);
#undef PK
}
__device__ __forceinline__ void pv_d0(f32x16* o, int vb, bf16x8 pa0, bf16x8 pa1, bf16x8 pa2, bf16x8 pa3) {
  pv_one<0>(o[0], vb, pa0, pa1, pa2, pa3); pv_one<1>(o[1], vb, pa0, pa1, pa2, pa3); pv_one<2>(o[2], vb, pa0, pa1, pa2, pa3); pv_one<3>(o[3], vb, pa0, pa1, pa2, pa3);
}
__device__ __forceinline__ void attn_dense_body(const bf16_t* __restrict__ Qb, const bf16_t* __restrict__ Kh, const bf16_t* __restrict__ Vh, void* __restrict__ Obv, int OBF, int seq, char* lds) {
  int tid_ = threadIdx.x; asm volatile("" : "+v"(tid_));
  const int tid = tid_, wid = tid >> 6, lane = tid & 63, r32 = lane & 31, hi = lane >> 5;
  bf16_t* V_lds = (bf16_t*)lds; bf16_t* K_lds = (bf16_t*)(lds + 2 * SHM_V);
  float* ws = (float*)(lds + 2 * SHM_V + 2 * SHM_K) + wid * 64; float* li_l = ws; float* al_l = ws + 32;
  float m_reg = -1e30f, l_reg = 0; f32x16 o[4] = {}; bf16x8 qr[8];
  const bf16_t* Qw = Qb + (long)(wid * QBLK + r32) * LDQ + hi * 8;
#pragma unroll
  for (int d0 = 0; d0 < 8; ++d0) qr[d0] = *reinterpret_cast<const bf16x8*>(Qw + d0 * 16);
  const int sr = tid >> 4, sc = (tid & 15) * 8, vst0 = v_st(sr, sc), vst1 = v_st(32 + sr, sc);
  const int vb0 = (int)(uintptr_t)V_lds + v_rd_base(lane);
  struct { bf16x8 vs0, vs1, ks0, ks1; } sr_[2];
#define SLOAD(i, k0) do { sr_[i].vs0 = *reinterpret_cast<const bf16x8*>(&Vh[(long)((k0) + sr) * LDK + sc]); sr_[i].vs1 = *reinterpret_cast<const bf16x8*>(&Vh[(long)((k0) + 32 + sr) * LDK + sc]); \
    sr_[i].ks0 = *reinterpret_cast<const bf16x8*>(&Kh[(long)((k0) + sr) * LDK + sc]); sr_[i].ks1 = *reinterpret_cast<const bf16x8*>(&Kh[(long)((k0) + 32 + sr) * LDK + sc]); } while (0)
#define SWRITE(b, i) do { *(bf16x8*)((char*)V_lds + (b) * SHM_V + vst0) = sr_[i].vs0;          \
    *(bf16x8*)((char*)V_lds + (b) * SHM_V + vst1) = sr_[i].vs1; int kc = sc * 2;               \
    *(bf16x8*)((char*)K_lds + (b) * SHM_K + KSWZ(sr, kc)) = sr_[i].ks0;                       \
    *(bf16x8*)((char*)K_lds + (b) * SHM_K + KSWZ(32 + sr, kc)) = sr_[i].ks1; } while (0)
#define SWAIT() asm volatile("s_waitcnt vmcnt(4)" ::: "memory")
#define RESC(a) do { if (__any((a) < 1.f)) { if (hi == 0) al_l[r32] = (a); asm volatile("s_waitcnt lgkmcnt(0)" ::: "memory"); \
    _Pragma("unroll") for (int d = 0; d < 4; ++d) _Pragma("unroll") for (int r = 0; r < 16; ++r) o[d][r] *= al_l[crow(r, hi)]; } } while (0)
  f32x16 pA0, pA1, pB0, pB1; float mnA, mnB, alA, alB; bf16x8 pa0, pa1, pa2, pa3; const int NT = seq / KVBLK;
  constexpr int SE = 0, SO = 1;
  SLOAD(SE, 0); asm volatile("s_waitcnt vmcnt(0)" ::: "memory"); SWRITE(0, SE); __syncthreads();
  qkt(pA0, pA1, K_lds, qr, r32, hi); partialSM(pA0, pA1, m_reg, mnA, alA);
  SLOAD(SO, KVBLK); if (2 < NT) SLOAD(SE, 2 * KVBLK);
  SWAIT(); SWRITE(1, SO); __syncthreads();
  for (int j = 1; j + 1 < NT; j += 2) {
    SBAR(); qkt(pB0, pB1, (bf16_t*)((char*)K_lds + SHM_K), qr, r32, hi);
    finishSM(pA0, pA1, alA, l_reg, pa0, pa1, pa2, pa3); SBAR();
    SLOAD(SO, (j + 2) * KVBLK); SBAR();
    pv_d0(o, vb0, pa0, pa1, pa2, pa3); partialSM(pB0, pB1, m_reg, mnB, alB);
    __syncthreads(); SWAIT(); SWRITE(0, SE);
    RESC(alB); __syncthreads();
    SBAR(); qkt(pA0, pA1, K_lds, qr, r32, hi);
    finishSM(pB0, pB1, alB, l_reg, pa0, pa1, pa2, pa3); SBAR();
    if (j + 3 < NT) SLOAD(SE, (j + 3) * KVBLK); SBAR();
    pv_d0(o, vb0 + (int)SHM_V, pa0, pa1, pa2, pa3); partialSM(pA0, pA1, m_reg, mnA, alA);
    __syncthreads(); SWAIT(); SWRITE(1, SO);
    RESC(alA); __syncthreads();
  }
  SBAR(); qkt(pB0, pB1, (bf16_t*)((char*)K_lds + SHM_K), qr, r32, hi);
  finishSM(pA0, pA1, alA, l_reg, pa0, pa1, pa2, pa3); SBAR();
  pv_d0(o, vb0, pa0, pa1, pa2, pa3); partialSM(pB0, pB1, m_reg, mnB, alB);
  __syncthreads(); RESC(alB);
  finishSM(pB0, pB1, alB, l_reg, pa0, pa1, pa2, pa3); SBAR();
  pv_d0(o, vb0 + (int)SHM_V, pa0, pa1, pa2, pa3);
  if (hi == 0) li_l[r32] = l_reg; asm volatile("s_waitcnt lgkmcnt(0)" ::: "memory");
  float rli[16];
#pragma unroll
  for (int r = 0; r < 16; ++r) rli[r] = __builtin_amdgcn_rcpf(li_l[crow(r, hi)]);
  if (OBF) {
    bf16_t* Ow = (bf16_t*)Obv + (long)(wid * QBLK) * LDO;
#pragma unroll
    for (int r = 0; r < 16; ++r) { int orow = crow(r, hi);
#pragma unroll
      for (int d0 = 0; d0 < 4; ++d0) Ow[(long)orow * LDO + d0 * 32 + r32] = (bf16_t)f2bf(o[d0][r] * rli[r]); }
  } else {
    float* Ow = (float*)Obv + (long)(wid * QBLK) * LDO;
#pragma unroll
    for (int r = 0; r < 16; ++r) { int orow = crow(r, hi);
#pragma unroll
      for (int d0 = 0; d0 < 4; ++d0) Ow[(long)orow * LDO + d0 * 32 + r32] = o[d0][r] * rli[r]; }
  }
#undef SLOAD
#undef SWRITE
#undef SWAIT
#undef RESC
}

__device__ __forceinline__ void attn_diff_body(const bf16_t* __restrict__ Qb, const bf16_t* __restrict__ Kh, const bf16_t* __restrict__ Vlo, const bf16_t* __restrict__ Vhi,
                                               float* __restrict__ Olo, float* __restrict__ Ohi, int seq, char* lds, char* lx) {
  int tid_ = threadIdx.x; asm volatile("" : "+v"(tid_));
  const int tid = tid_, wid = tid >> 6, lane = tid & 63, r32 = lane & 31, hi = lane >> 5, pw = wid & 3;
  char* VL = lds; char* VH = lds + 2 * SHM_V; char* KL = lds + 4 * SHM_V; char* PB = lds + 4 * SHM_V + 2 * SHM_K;
  float* AL = (float*)lx; float* LI = (float*)lx + 512;
  const int NT = seq / KVBLK;
  const int t2 = tid & 255, sr = t2 >> 4, sc = (t2 & 15) * 8;
  bf16x8 pa0, pa1, pa2, pa3;
  float* alw = AL + pw * 32;
#define RESCX(t) do { const float* al_ = alw + ((t) & 3) * 128; const float a_ = al_[r32]; if (__any(a_ < 1.f)) { \
    _Pragma("unroll") for (int d = 0; d < 8; ++d) _Pragma("unroll") for (int r = 0; r < 16; ++r) o[d][r] *= al_[crow(r, hi)]; } } while (0)
  if (wid < 4) {
    float m_reg = -1e30f, l_reg = 0; bf16x8 qr[8];
    const bf16_t* Qw = Qb + (long)(pw * QBLK + r32) * LDQ + hi * 8;
#pragma unroll
    for (int d0 = 0; d0 < 8; ++d0) qr[d0] = *reinterpret_cast<const bf16x8*>(Qw + d0 * 16);
    bf16x8 ka0, ka1, ka2, ka3;
#define KLOAD(S, k0) do { S##0 = *reinterpret_cast<const bf16x8*>(&Kh[(long)((k0) + sr) * LDK + sc]); S##1 = *reinterpret_cast<const bf16x8*>(&Kh[(long)((k0) + 16 + sr) * LDK + sc]); \
    S##2 = *reinterpret_cast<const bf16x8*>(&Kh[(long)((k0) + 32 + sr) * LDK + sc]); S##3 = *reinterpret_cast<const bf16x8*>(&Kh[(long)((k0) + 48 + sr) * LDK + sc]); } while (0)
#define KWRITE(b, S) do { const int kc = sc * 2; *(bf16x8*)(KL + (b) * SHM_K + KSWZ(sr, kc)) = S##0; *(bf16x8*)(KL + (b) * SHM_K + KSWZ(16 + sr, kc)) = S##1; \
    *(bf16x8*)(KL + (b) * SHM_K + KSWZ(32 + sr, kc)) = S##2; *(bf16x8*)(KL + (b) * SHM_K + KSWZ(48 + sr, kc)) = S##3; } while (0)
#define PWRITE(par) do { char* p_ = PB + (par) * 16384 + pw * 4096 + lane * 64; *(bf16x8*)p_ = pa0; *(bf16x8*)(p_ + 16) = pa1; *(bf16x8*)(p_ + 32) = pa2; *(bf16x8*)(p_ + 48) = pa3; } while (0)
#define AWRITE(t, a) do { if (hi == 0) alw[((t) & 3) * 128 + r32] = (a); } while (0)
    f32x16 pA0, pA1, pB0, pB1; float mnA, mnB, alA, alB;
    KLOAD(ka, 0); asm volatile("s_waitcnt vmcnt(0)" ::: "memory"); KWRITE(0, ka); __syncthreads();
    qkt(pA0, pA1, (const bf16_t*)KL, qr, r32, hi); partialSM(pA0, pA1, m_reg, mnA, alA); AWRITE(0, alA);
    KLOAD(ka, KVBLK);
    asm volatile("s_waitcnt vmcnt(0)" ::: "memory"); KWRITE(1, ka); __syncthreads();
    for (int j = 1; j + 1 < NT; j += 2) {
      KLOAD(ka, (j + 1) * KVBLK);
      SBAR(); qkt(pB0, pB1, (const bf16_t*)(KL + SHM_K), qr, r32, hi);
      finishSM(pA0, pA1, alA, l_reg, pa0, pa1, pa2, pa3); SBAR();
      PWRITE(0);
      partialSM(pB0, pB1, m_reg, mnB, alB); AWRITE(j, alB);
      __syncthreads();
      KWRITE(0, ka);
      __syncthreads();
      KLOAD(ka, (j + 2) * KVBLK);
      SBAR(); qkt(pA0, pA1, (const bf16_t*)KL, qr, r32, hi);
      finishSM(pB0, pB1, alB, l_reg, pa0, pa1, pa2, pa3); SBAR();
      PWRITE(1);
      partialSM(pA0, pA1, m_reg, mnA, alA); AWRITE(j + 1, alA);
      __syncthreads();
      KWRITE(1, ka);
      __syncthreads();
    }
    SBAR(); qkt(pB0, pB1, (const bf16_t*)(KL + SHM_K), qr, r32, hi);
    finishSM(pA0, pA1, alA, l_reg, pa0, pa1, pa2, pa3); SBAR();
    PWRITE(0);
    partialSM(pB0, pB1, m_reg, mnB, alB); AWRITE(NT - 1, alB);
    __syncthreads();
    __syncthreads();
    finishSM(pB0, pB1, alB, l_reg, pa0, pa1, pa2, pa3); SBAR();
    PWRITE(1);
    if (hi == 0) LI[pw * 32 + r32] = l_reg;
    __syncthreads();
    asm volatile("s_waitcnt vmcnt(0)" ::: "memory"); __syncthreads();
#undef KLOAD
#undef KWRITE
#undef PWRITE
#undef AWRITE
  } else {
    const int vbL = (int)(uintptr_t)VL + v_rd_base(lane), vbH = (int)(uintptr_t)VH + v_rd_base(lane);
    f32x16 o[8] = {};
    bf16x8 la0, la1, la2, la3, ha0, ha1, ha2, ha3, lb0, lb1, lb2, lb3, hb0, hb1, hb2, hb3;
#define VLOAD(S, k0) do { l##S##0 = *reinterpret_cast<const bf16x8*>(&Vlo[(long)((k0) + sr) * LDK + sc]); l##S##1 = *reinterpret_cast<const bf16x8*>(&Vlo[(long)((k0) + 16 + sr) * LDK + sc]); \
    l##S##2 = *reinterpret_cast<const bf16x8*>(&Vlo[(long)((k0) + 32 + sr) * LDK + sc]); l##S##3 = *reinterpret_cast<const bf16x8*>(&Vlo[(long)((k0) + 48 + sr) * LDK + sc]); \
    h##S##0 = *reinterpret_cast<const bf16x8*>(&Vhi[(long)((k0) + sr) * LDK + sc]); h##S##1 = *reinterpret_cast<const bf16x8*>(&Vhi[(long)((k0) + 16 + sr) * LDK + sc]); \
    h##S##2 = *reinterpret_cast<const bf16x8*>(&Vhi[(long)((k0) + 32 + sr) * LDK + sc]); h##S##3 = *reinterpret_cast<const bf16x8*>(&Vhi[(long)((k0) + 48 + sr) * LDK + sc]); } while (0)
#define VWRITE(b, S) do { *(bf16x8*)(VL + (b) * SHM_V + v_st(sr, sc)) = l##S##0; *(bf16x8*)(VL + (b) * SHM_V + v_st(16 + sr, sc)) = l##S##1; \
    *(bf16x8*)(VL + (b) * SHM_V + v_st(32 + sr, sc)) = l##S##2; *(bf16x8*)(VL + (b) * SHM_V + v_st(48 + sr, sc)) = l##S##3; \
    *(bf16x8*)(VH + (b) * SHM_V + v_st(sr, sc)) = h##S##0; *(bf16x8*)(VH + (b) * SHM_V + v_st(16 + sr, sc)) = h##S##1; \
    *(bf16x8*)(VH + (b) * SHM_V + v_st(32 + sr, sc)) = h##S##2; *(bf16x8*)(VH + (b) * SHM_V + v_st(48 + sr, sc)) = h##S##3; } while (0)
#define XSTEP(t) do { const char* p_ = PB + ((t) & 1) * 16384 + pw * 4096 + lane * 64; pa0 = *(const bf16x8*)p_; pa1 = *(const bf16x8*)(p_ + 16); pa2 = *(const bf16x8*)(p_ + 32); pa3 = *(const bf16x8*)(p_ + 48); \
    if ((t) >= 1) RESCX(t); pv_d0(o, vbL + ((t) & 1) * (int)SHM_V, pa0, pa1, pa2, pa3); pv_d0(o + 4, vbH + ((t) & 1) * (int)SHM_V, pa0, pa1, pa2, pa3); } while (0)
    VLOAD(a, 0); asm volatile("s_waitcnt vmcnt(0)" ::: "memory"); VWRITE(0, a); __syncthreads();
    VLOAD(b, KVBLK);
    __syncthreads();
    for (int j = 1; j + 1 < NT; j += 2) {
      VLOAD(a, (j + 1) * KVBLK);
      if (j >= 3) XSTEP(j - 2);
      __syncthreads();
      asm volatile("s_waitcnt vmcnt(8)" ::: "memory"); VWRITE(1, b);
      __syncthreads();
      if (j + 2 < NT) VLOAD(b, (j + 2) * KVBLK);
      XSTEP(j - 1);
      __syncthreads();
      if (j + 2 < NT) asm volatile("s_waitcnt vmcnt(8)" ::: "memory"); else asm volatile("s_waitcnt vmcnt(0)" ::: "memory");
      VWRITE(0, a);
      __syncthreads();
    }
    XSTEP(NT - 3);
    __syncthreads();
    asm volatile("s_waitcnt vmcnt(0)" ::: "memory"); VWRITE(1, b);
    __syncthreads();
    XSTEP(NT - 2);
    __syncthreads();
    XSTEP(NT - 1);
#undef VLOAD
#undef VWRITE
#undef XSTEP
    asm volatile("s_waitcnt lgkmcnt(0)" ::: "memory");
    float rli[16];
#pragma unroll
    for (int r = 0; r < 16; ++r) rli[r] = __builtin_amdgcn_rcpf(LI[pw * 32 + crow(r, hi)]);
    float* Owl = Olo + (long)(pw * QBLK) * LDO; float* Owh = Ohi + (long)(pw * QBLK) * LDO;
#pragma unroll
    for (int r = 0; r < 16; ++r) { const int orow = crow(r, hi);
#pragma unroll
      for (int d0 = 0; d0 < 4; ++d0) { Owl[(long)orow * LDO + d0 * 32 + r32] = o[d0][r] * rli[r]; Owh[(long)orow * LDO + d0 * 32 + r32] = o[4 + d0][r] * rli[r]; } }
    asm volatile("s_waitcnt vmcnt(0)" ::: "memory"); __syncthreads();
  }
#undef RESCX
}
}

struct Args { const float* in[22]; float* out; unsigned char* ws; int ph_lo, ph_hi, li, pad; };
enum { I_X = 0, I_C, I_CTX, I_CCTX, I_WADA, I_BADA, I_WIN, I_LAMBDA, I_SUBLN, I_QKG, I_WBR, I_WGATE, I_BGATE, I_WO, I_LN1G, I_LN1B, I_WUP, I_CONVW, I_CONVB, I_WDOWN, I_LN2G, I_LN2B };

__device__ __forceinline__ const float* inp(int i) { int off = i * 8; asm volatile("" : "+s"(off));
    const GAS float* p = *(const GAS float* const __attribute__((address_space(4)))*)((const __attribute__((address_space(4))) char*)__builtin_amdgcn_kernarg_segment_ptr() + off);
    return (const float*)p; }
#define WSP(T, OFF) ((T*)(wsp + (OFF)))
#define PH_BEGIN size_t zoff_ = 0; asm volatile("" : "+s"(zoff_)); unsigned char* wsp = args.ws + zoff_; int tid_p = threadIdx.x; asm volatile("" : "+v"(tid_p)); const int tid = tid_p, lane = tid_p & 63; (void)tid; (void)lane

template <int MODE>
__device__ __forceinline__ void transpose_item(const float* W, int K, int N, bf16_t* WT, int row_off, LAS float* scr, int item, int lane) {
    const int nblk = N / 32, kb = item / nblk, nb = item - kb * nblk, k0 = 64 * kb, n0 = 32 * nb;
    if (MODE == 1) { const int isg = n0 >= DFF, f = n0 - isg * DFF; row_off = (f >> 7) * 256 + isg * 128 + (f & 127) - n0; }
    const bool il = (MODE == 2) && (n0 < 4096 || (n0 >= 8192 && n0 < 10752));
    float tv[32];
#pragma unroll
    for (int i = 0; i < 32; ++i) { const int kk = 2 * i + (lane >> 5); tv[i] = W[(size_t)(k0 + kk) * N + n0 + (lane & 31)]; }
#pragma unroll
    for (int i = 0; i < 32; ++i) { const int kk = 2 * i + (lane >> 5); scr[kk * 33 + (lane & 31)] = tv[i]; }
    LDS_WAIT(); asm volatile("" ::: "memory");
    const int c = lane & 7;
#pragma unroll
    for (int j = 0; j < 4; ++j) { const int n = (lane >> 3) + 8 * j; const LAS float* s = scr + (8 * c) * 33 + n;
        u32x4 o; o.x = pk2(s[0 * 33], s[1 * 33]); o.y = pk2(s[2 * 33], s[3 * 33]); o.z = pk2(s[4 * 33], s[5 * 33]); o.w = pk2(s[6 * 33], s[7 * 33]);
        int drow = row_off + n0 + n; if (il) { const int cn = n0 + n, d = cn & 127; drow = row_off + (cn & ~127) + 2 * (d & 63) + (d >> 6); }
        *(u32x4*)(WT + (size_t)drow * K + k0 + 8 * c) = o; }
    LDS_WAIT(); asm volatile("" ::: "memory");
}

__device__ __forceinline__ void ln_row(const float* yrow, const float* g, const float* bb, float* Xo, bf16_t* Ho, const float* sc, const float* sh, float* Oo, int lane, const float* yp = nullptr, const float* xrow = nullptr, const float* gate = nullptr) {
    f32x4 v[16]; float s = 0.f;
#pragma unroll
    for (int j = 0; j < 16; ++j) { const int c = 256 * j + 4 * lane;
        if (yp) { f32x4 a = *(const f32x4*)(yp + c);
#pragma unroll
            for (int sp = 1; sp < 8; ++sp) a += *(const f32x4*)(yp + (size_t)sp * 512 * DM + c);
            v[j] = *(const f32x4*)(xrow + c) * DN_ALPHA + *(const f32x4*)(gate + c) * a; }
        else v[j] = *(const f32x4*)(yrow + c);
        s += (v[j].x + v[j].y) + (v[j].z + v[j].w); }
    const float mean = wave_sum(s) * (1.f / DM); float s2 = 0.f;
#pragma unroll
    for (int j = 0; j < 16; ++j) { v[j] = v[j] - mean; s2 += (v[j].x * v[j].x + v[j].y * v[j].y) + (v[j].z * v[j].z + v[j].w * v[j].w); }
    const float rstd = 1.f / sqrtf(wave_sum(s2) * (1.f / DM) + NORM_EPS);
#pragma unroll
    for (int j = 0; j < 16; ++j) { const int c = 256 * j + 4 * lane;
        const f32x4 x = v[j] * rstd * *(const f32x4*)(g + c) + *(const f32x4*)(bb + c);
        if (Xo) *(f32x4*)(Xo + c) = x;
        if (Oo) *(f32x4*)(Oo + c) = x;
        if (Ho) { const f32x4 h = x * (*(const f32x4*)(sc + c) + 1.0f) + *(const f32x4*)(sh + c);
            u32x2 w; w.x = cvt_pk_bf16(h.x, h.y); w.y = cvt_pk_bf16(h.z, h.w); *(u32x2*)(Ho + c) = w; } }
}

__global__ void __launch_bounds__(NTHREADS, 2) fwd(Args args) {
    extern __shared__ __attribute__((aligned(16))) unsigned char lds_raw[];
    LAS unsigned char* lds = (LAS unsigned char*)lds_raw;
    const int tid0 = threadIdx.x, wave = __builtin_amdgcn_readfirstlane(tid0 >> 6);
    const int G = gridDim.x, bx = blockIdx.x;
    const int vcu = (G % 8 == 0) ? (bx % 8) * (G / 8) + bx / 8 : bx;
    const int gw = vcu * NWAVES + wave, NGW = G * NWAVES;
    unsigned* ctl = (unsigned*)(args.ws + WS_CTL);
    for (int u = tid0; u < (LDS_BYTES - LDSCTL_OFF) / 4; u += NTHREADS) ((LAS unsigned*)(lds + LDSCTL_OFF))[u] = 0u;
    __syncthreads();
    XcdBarrier bar; bar.bar = ctl + 4096; bar.x = 0; bar.st = nullptr;
    if (MK_N_LAUNCHES == 1) bar = xcd_barrier_post(ctl + 4096, (volatile LAS unsigned*)(lds + LDSCTL_OFF + 64));
    const int lo = args.ph_lo, hi = args.ph_hi;
#ifndef PHMASK
#define PHMASK 0xFFFFFFFFu
#endif
#define PHB(k) ((PHMASK >> (k)) & 1u)
#ifndef REPMASK
#define REPMASK 0u
#endif
#define REPN(k) (1 + (int)((REPMASK >> (k)) & 1u))
#define REP_BEGIN(k) for (int rep_ = 0; rep_ < REPN(k); ++rep_) {
#define REP_END(k) if (rep_ + 1 < REPN(k)) xcd_barrier(bar); }
#define IN(k) (lo <= (k) && (k) < hi)
#define SEAM(k) do { if (IN(k) && IN((k) + 1)) xcd_barrier(bar); } while (0)

    REP_BEGIN(0)
    if (PHB(0) && IN(0)) {
        PH_BEGIN;
        { LAS float* sv = (LAS float*)lds;
          float* MODP = WSP(float, WS_MODP); const float* pc = inp(I_C); const float* pcc = inp(I_CCTX); const float* wada = inp(I_WADA);
          LAS float* red = (LAS float*)(lds + 49152);
          for (int i = tid; i < 3 * DM; i += NTHREADS) { const int j = i / DM, k = i - j * DM; const float c = (j < 2) ? pc[j * DM + k] : pcc[k]; sv[i] = c * sigmoidf_(c); }
          __syncthreads();
          for (int it = bx; it < 768; it += G) {
              const int l = it / 384, r = it - l * 384, cg = r >> 1, kh = r & 1;
              const float* W = wada + (size_t)l * DM * NADA + cg * 128 + 4 * (lane & 31);
              const int kbase = kh * 2048 + wave * 256 + (lane >> 5);
              f32x4 a0 = {0.f, 0.f, 0.f, 0.f}, a1 = a0, a2 = a0;
#pragma unroll 8
              for (int i = 0; i < 128; ++i) { const int k = kbase + 2 * i; const f32x4 w = *(const f32x4*)(W + (size_t)k * NADA);
                  a0 += w * sv[k]; a1 += w * sv[DM + k]; a2 += w * sv[2 * DM + k]; }
#pragma unroll
              for (int j = 0; j < 4; ++j) { a0[j] += __shfl_xor(a0[j], 32); a1[j] += __shfl_xor(a1[j], 32); a2[j] += __shfl_xor(a2[j], 32); }
              if (lane < 32) { *(LAS f32x4*)(red + (wave * 3 + 0) * 128 + 4 * lane) = a0; *(LAS f32x4*)(red + (wave * 3 + 1) * 128 + 4 * lane) = a1; *(LAS f32x4*)(red + (wave * 3 + 2) * 128 + 4 * lane) = a2; }
              __syncthreads();
              if (tid < 384) { float s = 0.f;
#pragma unroll
                  for (int w8 = 0; w8 < 8; ++w8) s += red[w8 * 384 + tid];
                  const int j = tid >> 7, n = tid & 127;
                  MODP[((size_t)(l * 2 + kh) * 3 + j) * NADA + cg * 128 + n] = s; }
              __syncthreads();
          }
        }
        { LAS float* ct = (LAS float*)lds; LAS float* st = ct + 4096;
          for (int i = tid; i < 4096; i += NTHREADS) { const float a = (float)i * (1.0f / 2048.0f); ct[i] = cospif(a); st[i] = sinpif(a); }
          __syncthreads();
          const int gt = vcu * NTHREADS + tid, NGT = G * NTHREADS;
          bf16_t* FM = WSP(bf16_t, WS_F); bf16_t* FCTX = WSP(bf16_t, WS_FCTX); bf16_t* DC = WSP(bf16_t, WS_DC); float* ROPE = WSP(float, WS_ROPE);
          for (int i = gt; i < 4096 * 512; i += NGT) { const int r = i >> 9, k8 = (i & 511) * 8; const int np = (r <= 2048) ? r : r - 2048; const float sg = (r <= 2048) ? -(1.0f / 64.0f) : (1.0f / 64.0f);
              float v[8];
#pragma unroll
              for (int e = 0; e < 8; ++e) { const int k = k8 + e; v[e] = (k <= 2048) ? ct[(np * k) & 4095] * (1.0f / 64.0f) : sg * st[(np * (k - 2048)) & 4095]; }
              u32x4 w; w.x = pk2(v[0], v[1]); w.y = pk2(v[2], v[3]); w.z = pk2(v[4], v[5]); w.w = pk2(v[6], v[7]);
              *(u32x4*)(FM + (size_t)r * 4096 + k8) = w; }
          for (int i = gt; i < 256 * 512; i += NGT) { const int np = i >> 9, c = i & 511; const bool sn = c >= 256; const int idx = ((np * (c & 255)) & 255) * 16;
              FCTX[i] = (bf16_t)f2bf(sn ? -st[idx] * (1.0f / 16.0f) : ct[idx] * (1.0f / 16.0f)); }
          for (int i = gt; i < 512 * 256; i += NGT) { const int r = i >> 8, c = i & 255; const bool sn = r >= 256; const int idx = (((r & 255) * c) & 255) * 16;
              DC[i] = (bf16_t)f2bf(sn ? st[idx] * (1.0f / 16.0f) : ct[idx] * (1.0f / 16.0f)); }
          for (int i = gt; i < 4096 * 64; i += NGT) { const int t = i >> 6, f = i & 63; const float pos = (f < 32) ? (float)(t >> 6) : (float)(t & 63);
              const float inv = exp2f(-(float)(f & 31) * (13.287712379549449f / 32.0f));
              double xr = (double)pos * (double)inv * 0.31830988618379067; xr -= 2.0 * floor(xr * 0.5);
              ROPE[2 * i] = cospif((float)xr); ROPE[2 * i + 1] = sinpif((float)xr); }
          __syncthreads();
        }
        { LAS float* scr = (LAS float*)(lds + wave * 16384);
          constexpr int IT_IN = 64 * 352, IT_G = 64 * 384, IT_B = 32 * 128, IT_O = 64 * 128, IT_UP = 64 * 688, IT_DN = 172 * 128;
          constexpr int IT_LAYER = IT_IN + IT_G + 3 * IT_B + IT_O + IT_UP + IT_DN;
          const float* p_win = inp(I_WIN); const float* p_wg = inp(I_WGATE); const float* p_wbr = inp(I_WBR); const float* p_wo = inp(I_WO); const float* p_wup = inp(I_WUP); const float* p_wdn = inp(I_WDOWN);
          for (int it = gw; it < NLAYER * IT_LAYER; it += NGW) {
              const int l = it / IT_LAYER; int r = it - l * IT_LAYER;
              unsigned char* wl = wsp + WS_W + (size_t)l * W_LAYER;
              if (r < IT_IN) { transpose_item<2>(p_win + (size_t)l * DM * DIN, DM, DIN, (bf16_t*)(wl + W_1), 0, scr, r, lane); continue; } r -= IT_IN;
              if (r < IT_G) { transpose_item<0>(p_wg + (size_t)l * DM * NGATE, DM, NGATE, (bf16_t*)(wl + W_1), DIN, scr, r, lane); continue; } r -= IT_G;
              if (r < 3 * IT_B) { const int n = r / IT_B; r -= n * IT_B; transpose_item<0>(p_wbr + ((size_t)l * 3 + n) * BW * DM, BW, DM, (bf16_t*)(wl + W_B) + (size_t)n * DM * BW, 0, scr, r, lane); continue; } r -= 3 * IT_B;
              if (r < IT_O) { transpose_item<0>(p_wo + (size_t)l * DM * DM, DM, DM, (bf16_t*)(wl + W_O), 0, scr, r, lane); continue; } r -= IT_O;
              if (r < IT_UP) { transpose_item<1>(p_wup + (size_t)l * DM * NUP, DM, NUP, (bf16_t*)(wl + W_UP), 0, scr, r, lane); continue; } r -= IT_UP;
              transpose_item<0>(p_wdn + (size_t)l * DFF * DM, DFF, DM, (bf16_t*)(wl + W_DN), 0, scr, r, lane);
          }
        }
    }
        REP_END(0)
    SEAM(0);
    REP_BEGIN(1)
    if (PHB(1) && IN(1)) {
        PH_BEGIN;
        const int gt = vcu * NTHREADS + tid, NGT = G * NTHREADS;
        float* MODP = WSP(float, WS_MODP); float* MOD = WSP(float, WS_MOD); bf16_t* H = WSP(bf16_t, WS_H); const float* bada = inp(I_BADA); const float* px = inp(I_X); const float* pctx = inp(I_CTX);
        for (int i = gt; i < NLAYER * 3 * NADA; i += NGT) { const int l = i / (3 * NADA), r = i - l * 3 * NADA, j = r / NADA, n = r - j * NADA;
            MOD[i] = MODP[((size_t)(l * 2 + 0) * 3 + j) * NADA + n] + MODP[((size_t)(l * 2 + 1) * 3 + j) * NADA + n] + bada[l * NADA + n]; }
        for (int i = gt; i < M * (DM / 4); i += NGT) { const int row = i >> 10, c4 = (i & 1023) * 4; const int b = row / LT, p = row - b * LT, j = (p < CTX) ? 2 : b;
            const size_t o0 = ((size_t)(0 * 2 + 0) * 3 + j) * NADA, o1 = ((size_t)(0 * 2 + 1) * 3 + j) * NADA;
            const f32x4 sh = *(const f32x4*)(MODP + o0 + c4) + *(const f32x4*)(MODP + o1 + c4) + *(const f32x4*)(bada + c4);
            const f32x4 sc = *(const f32x4*)(MODP + o0 + DM + c4) + *(const f32x4*)(MODP + o1 + DM + c4) + *(const f32x4*)(bada + DM + c4);
            const f32x4 x = *(const f32x4*)((p < CTX) ? pctx + ((size_t)(b * CTX + p)) * DM + c4 : px + ((size_t)(b * SEQ + p - CTX)) * DM + c4);
            const f32x4 h = x * (sc + 1.0f) + sh;
            u32x2 w; w.x = cvt_pk_bf16(h.x, h.y); w.y = cvt_pk_bf16(h.z, h.w); *(u32x2*)(H + (size_t)row * DM + c4) = w; }
    }
        REP_END(1)
    SEAM(1);

#pragma unroll 1
    for (int l = 0; l < NLAYER; ++l) {
        const int P0 = PH_PRO + l * PH_PER_LAYER;
        const bool lastl = (l == NLAYER - 1);
#define WL (wsp + WS_W + (size_t)l * W_LAYER)
#define MODL (WSP(float, WS_MOD) + (size_t)l * 3 * NADA)
        const float lam_init = 0.8f - 0.6f * expf(-0.3f * (float)l);

        REP_BEGIN(2)
        if (PHB(2) && IN(P0 + 0)) {
            PH_BEGIN;
            pg8::Gemm g{WSP(bf16_t, WS_H), (const bf16_t*)(WL + W_1), DM, DM, DM, 0, 0};
            pg8::TileOrder<1> S; S.init(M / 256, N1 / 256, 1, G, bx, lastl, lastl ? 40 : 0);
            pg8::EpiProj E{WSP(bf16_t, WS_PG), inp(I_BGATE) + (size_t)l * NGATE, inp(I_QKG) + (size_t)l * 2 * 128, WSP(float, WS_ROPE), (LAS float*)(lds + LDS_EX_OFF), WSP(bf16_t, WS_KV)};
            pg8::gemm_phase<pg8::EpiProj, pg8::TileOrder<1>>(lds, g, S, E);
        }
        REP_END(2)
        SEAM(P0 + 0);
        REP_BEGIN(3)
        if (PHB(3) && IN(P0 + 1)) {
            PH_BEGIN;
            bf16_t* PG = WSP(bf16_t, WS_PG);
            { pg8::Gemm g{WSP(bf16_t, WS_DC), PG + C_BU, 256, N1, 256, 0, 256};
              pg8::TileOrder<1> S; S.init(2, M / 256, 8, G, bx);
              pg8::EpiF1 E{WSP(bf16_t, WS_YT), WSP(bf16_t, WS_YTC)};
              pg8::gemm_phase<pg8::EpiF1, pg8::TileOrder<1>>(lds, g, S, E);
            }
            xcd_barrier(bar);
            {
              const bf16_t* YT = WSP(bf16_t, WS_YT); bf16_t* YF = WSP(bf16_t, WS_YF);
              const int gt = vcu * NTHREADS + tid, NGT = G * NTHREADS;
              for (int idx = gt; idx < 4096 * 512; idx += NGT) { const int row = idx >> 9, k8 = (idx & 511) * 8;
                  const bf16_t* yc = YT + (size_t)row * 8192; const bf16_t* ys = yc + 4096;
                  const bool sn = k8 >= 2048; const bf16_t* src = sn ? ys : yc; const int s8 = sn ? k8 - 2048 : k8;
                  const u32x4 a = *(const u32x4*)(src + s8), m0 = *(const u32x4*)(src + 4096 - s8 - 8);
                  u32x4 m1 = {0u, 0u, 0u, 0u}; if (s8 > 0) m1 = *(const u32x4*)(src + 4096 - s8);
                  const unsigned aw[4] = {a.x, a.y, a.z, a.w}, mw[4] = {m0.x, m0.y, m0.z, m0.w};
                  float av[8], mv[8];
#pragma unroll
                  for (int q = 0; q < 4; ++q) { av[2 * q] = bflo(aw[q]); av[2 * q + 1] = bfhi(aw[q]); }
                  mv[0] = bflo(m1.x);
#pragma unroll
                  for (int e = 1; e < 8; ++e) { const int p = 8 - e; mv[e] = (p & 1) ? bfhi(mw[p >> 1]) : bflo(mw[p >> 1]); }
                  float ov[8];
#pragma unroll
                  for (int e = 0; e < 8; ++e) ov[e] = sn ? av[e] - mv[e] : av[e] + mv[e];
                  if (sn && s8 == 0) ov[0] = bflo(*(const unsigned*)(yc + 2048));
                  u32x4 w; w.x = pk2(ov[0], ov[1]); w.y = pk2(ov[2], ov[3]); w.z = pk2(ov[4], ov[5]); w.w = pk2(ov[6], ov[7]);
                  *(u32x4*)(YF + (size_t)row * 4096 + k8) = w; }
            }
        }
        REP_END(3)
        SEAM(P0 + 1);
        REP_BEGIN(4)
        if (PHB(4) && IN(P0 + 2)) {
            PH_BEGIN;
            const bf16_t* PG = WSP(bf16_t, WS_PG); const bf16_t* KVB = WSP(bf16_t, WS_KV); float* OA1 = WSP(float, WS_OA1); float* OA2 = WSP(float, WS_OA2); bf16_t* BR = WSP(bf16_t, WS_BR);
            const float* lp = inp(I_LAMBDA) + (size_t)l * 4 * 128; const float* sgp = inp(I_SUBLN) + (size_t)l * 256;
            for (int pass = 0; pass < (lastl ? 2 : 4); ++pass) {
                const int nit = (pass == 0) ? 512 : (pass == 1) ? 256 : (pass == 2) ? 32 : 16;
                const int c0 = (pass == 3) ? (bx + G - (32 % G)) % G : bx;
                for (int L = c0; L < nit; L += G) {
                    int it = L; if (pass < 2) { const int q = nit / 8; it = (L % 8) * q + L / 8; }
                    const bool grp = (pass & 1);
                    int b, qrow, seq, hsel;
                    if (pass == 0) { b = it >> 8; const int r = it & 255; hsel = (r >> 6) * 4 + ((r >> 4) & 3); qrow = b * LT + CTX + (r & 15) * 256; seq = LT; }
                    else if (pass == 1) { b = it >> 7; hsel = (it >> 4) & 7; qrow = b * LT + CTX + (it & 15) * 256; seq = LT; }
                    else if (pass == 2) { b = it >> 4; hsel = it & 15; qrow = b * LT; seq = CTX; }
                    else { b = it >> 3; hsel = it & 7; qrow = b * LT; seq = CTX; }
                    if (!grp) { const int kvh = hsel >> 2;
                        att::attn_dense_body(PG + (size_t)qrow * N1 + C_CQ + hsel * 128, KVB + (size_t)(b * 40 + 32 + kvh) * LT * 128, KVB + (size_t)(b * 40 + 36 + kvh) * LT * 128,
                                             (void*)(BR + (size_t)2 * M * BW + (size_t)qrow * BW + hsel * 128), 1, seq, (char*)lds_raw);
                        __syncthreads(); }
                    else for (int j = 0; j < 4; ++j) { const int mp = j >> 1, rh = j & 1;
                        float* Ol = (mp ? OA2 : OA1) + (size_t)(qrow + rh * 128) * BW + hsel * 256;
                        att::attn_diff_body(PG + (size_t)(qrow + rh * 128) * N1 + C_AQ + hsel * 256 + mp * 128, KVB + (size_t)(b * 40 + hsel * 2 + mp) * LT * 128,
                                            KVB + (size_t)(b * 40 + 16 + hsel * 2) * LT * 128, KVB + (size_t)(b * 40 + 17 + hsel * 2) * LT * 128, Ol, Ol + 128, seq, (char*)lds_raw, (char*)lds_raw + LDS_EX_OFF); }
                    if (grp) {
                        VM_WAIT();
                        int lz = tid & 63; asm volatile("" : "+v"(lz));
                        const float d1 = wave_sum(lp[lz] * lp[128 + lz] + lp[64 + lz] * lp[192 + lz]);
                        const float d2 = wave_sum(lp[256 + lz] * lp[384 + lz] + lp[320 + lz] * lp[448 + lz]);
                        const float lam = expf(d1) - expf(d2) + lam_init;
                        const f32x4 sgv = *(const f32x4*)(sgp + 4 * lz) * (1.0f - lam_init);
                        for (int r0 = 0; r0 < 32; r0 += 8) { f32x4 dv[8];
#pragma unroll
                            for (int r = 0; r < 8; ++r) { const size_t off = (size_t)(qrow + wave * 32 + r0 + r) * BW + hsel * 256 + 4 * lz;
                                dv[r] = *(const f32x4*)(OA1 + off) - *(const f32x4*)(OA2 + off) * lam; }
#pragma unroll
                            for (int r = 0; r < 8; ++r) { const size_t off = (size_t)(qrow + wave * 32 + r0 + r) * BW + hsel * 256 + 4 * lz;
                                const f32x4 d = dv[r];
                                const float ss = wave_sum((d.x * d.x + d.y * d.y) + (d.z * d.z + d.w * d.w));
                                const float rr = 1.0f / sqrtf(ss * (1.0f / 256.0f) + NORM_EPS);
                                const f32x4 o = d * rr * sgv;
                                u32x2 w; w.x = cvt_pk_bf16(o.x, o.y); w.y = cvt_pk_bf16(o.z, o.w); *(u32x2*)(BR + off) = w; } }
                    }
                }
            }
            VM_WAIT(); __syncthreads();
            { pg8::Gemm g{WSP(bf16_t, WS_F), WSP(bf16_t, WS_YF), 4096, 4096, 4096, 0, (size_t)256 * 4096};
              pg8::OrdZ S{G, bx, 256, 4};
              pg8::EpiF2 E{BR + (size_t)1 * M * BW, CTX, 1};
              pg8::gemm_phase<pg8::EpiF2, pg8::OrdZ>(lds, g, S, E);
            }
            if (!lastl) {
              pg8::Gemm g{WSP(bf16_t, WS_FCTX), WSP(bf16_t, WS_YTC), 512, 512, 512, 0, (size_t)256 * 512};
              pg8::OrdZ S{G, bx, 16, 0};
              pg8::EpiF2 E{BR + (size_t)1 * M * BW, 0, 0};
              pg8::gemm_phase<pg8::EpiF2, pg8::OrdZ>(lds, g, S, E);
            }
        }
        REP_END(4)
        SEAM(P0 + 2);
        REP_BEGIN(5)
        if (PHB(5) && IN(P0 + 3)) {
            PH_BEGIN;
            pg8::Gemm g{WSP(bf16_t, WS_BR), (const bf16_t*)(WL + W_B), BW, BW, BW, (size_t)M * BW, (size_t)DM * BW};
            pg8::TileOrder<3> S; S.init(M / 256, DM / 256, 1, G, bx, lastl);
            pg8::EpiBranch E{WSP(bf16_t, WS_PG) + C_G, WSP(bf16_t, WS_MB)};
            pg8::gemm_phase<pg8::EpiBranch, pg8::TileOrder<3>>(lds, g, S, E);
        }
        REP_END(5)
        SEAM(P0 + 3);
        REP_BEGIN(6)
        if (PHB(6) && IN(P0 + 4)) {
            PH_BEGIN;
            pg8::Gemm g{WSP(bf16_t, WS_MB), (const bf16_t*)(WL + W_O), DM, DM, DM, 0, 0};
            pg8::EpiResid E{WSP(float, WS_X), WSP(float, WS_Y), MODL + 2 * DM, WSP(float, WS_YP), (l == 0) ? inp(I_X) : nullptr, inp(I_CTX)};
            pg8::SplitOrder S; S.init(G, bx, 8, 8, lastl ? 0 : 256); pg8::gemm_phase<pg8::EpiResid, pg8::SplitOrder, true>(lds, g, S, E);
        }
        REP_END(6)
        SEAM(P0 + 4);
        REP_BEGIN(7)
        if (PHB(7) && IN(P0 + 5)) {
            PH_BEGIN;
            const float* Y = WSP(float, WS_Y); float* X = WSP(float, WS_X); bf16_t* H = WSP(bf16_t, WS_H); const float* modl = MODL; const float* YP = WSP(float, WS_YP); const float* ctxin = inp(I_CTX);
            const float* g1 = inp(I_LN1G) + (size_t)l * DM; const float* b1 = inp(I_LN1B) + (size_t)l * DM;
            for (int row = gw; row < M; row += NGW) { const int b = row / LT, p = row - b * LT, j = (p < CTX) ? 2 : b;
                if (lastl && p < CTX) continue;
                const bool cp = p < CTX;
                ln_row(Y + (size_t)row * DM, g1, b1, X + (size_t)row * DM, H + (size_t)row * DM, modl + (size_t)j * NADA + 4 * DM, modl + (size_t)j * NADA + 3 * DM, nullptr, lane,
                       cp ? YP + (size_t)(b * 256 + p) * DM : nullptr, ctxin + (size_t)(b * CTX + (cp ? p : 0)) * DM, modl + (size_t)j * NADA + 2 * DM); }
        }
        REP_END(7)
        SEAM(P0 + 5);
        REP_BEGIN(8)
        if (PHB(8) && IN(P0 + 6)) {
            PH_BEGIN;
            pg8::Gemm g{WSP(bf16_t, WS_H), (const bf16_t*)(WL + W_UP), DM, DM, DM, 0, 0};
            pg8::TileOrder<1> S; S.init(M / 256, NUP / 256, 1, G, bx, lastl);
            pg8::EpiConv E{WSP(bf16_t, WS_U2), inp(I_CONVW) + (size_t)l * 3 * DFF, inp(I_CONVB) + (size_t)l * DFF, WSP(float, WS_AE), WSP(float, WS_CP), WSP(float, WS_GP), (LAS float*)(lds + LDS_EX_OFF)};
            pg8::gemm_phase<pg8::EpiConv, pg8::TileOrder<1>>(lds, g, S, E);
        }
        REP_END(8)
        SEAM(P0 + 6);
        REP_BEGIN(9)
        if (PHB(9) && IN(P0 + 7)) {
            PH_BEGIN;
            bf16_t* U2 = WSP(bf16_t, WS_U2); const float* AE = WSP(float, WS_AE); const float* CP = WSP(float, WS_CP); const float* GP = WSP(float, WS_GP);
            const float* cw = inp(I_CONVW) + (size_t)l * 3 * DFF;
            const int gt = vcu * NTHREADS + tid, NGT = G * NTHREADS;
            for (int idx = gt; idx < 34 * 2 * (DFF / 4); idx += NGT) { const int te = idx / (DFF / 4), f4 = (idx - te * (DFF / 4)) * 4, tile = te >> 1, e = te & 1, pt = tile % 17;
                if (lastl && pt == 0) continue;
                f32x4 c = *(const f32x4*)(CP + (size_t)te * DFF + f4); const f32x4 g = *(const f32x4*)(GP + (size_t)te * DFF + f4);
                if (e == 0 && pt >= 2) c += *(const f32x4*)(cw + f4) * *(const f32x4*)(AE + (size_t)((tile - 1) * 2 + 1) * DFF + f4);
                if (e == 1 && pt >= 1 && pt <= 15) c += *(const f32x4*)(cw + 2 * DFF + f4) * *(const f32x4*)(AE + (size_t)((tile + 1) * 2 + 0) * DFF + f4);
                const f32x2 g0 = gelu_pk((f32x2){c[0], c[1]}), g1 = gelu_pk((f32x2){c[2], c[3]});
                u32x2 w; w.x = cvt_pk_bf16(g0.x * g[0], g0.y * g[1]); w.y = cvt_pk_bf16(g1.x * g[2], g1.y * g[3]);
                *(u32x2*)(U2 + (size_t)(tile * 256 + e * 255) * DFF + f4) = w; }
        }
        REP_END(9)
        SEAM(P0 + 7);
        REP_BEGIN(10)
        if (PHB(10) && IN(P0 + 8)) {
            PH_BEGIN;
            pg8::Gemm g{WSP(bf16_t, WS_U2), (const bf16_t*)(WL + W_DN), DFF, DFF, DFF, 0, 0};
            pg8::EpiResid E{WSP(float, WS_X), WSP(float, WS_Y), MODL + 5 * DM, WSP(float, WS_YP), nullptr, nullptr};
            pg8::SplitOrder S; S.init(G, bx, 22, 20, lastl ? 0 : 256); pg8::gemm_phase<pg8::EpiResid, pg8::SplitOrder, true>(lds, g, S, E);
        }
        REP_END(10)
        SEAM(P0 + 8);
        REP_BEGIN(11)
        if (PHB(11) && IN(P0 + 9)) {
            PH_BEGIN;
            const float* Y = WSP(float, WS_Y); float* X = WSP(float, WS_X); bf16_t* H = WSP(bf16_t, WS_H); float* outp = args.out; const float* YP = WSP(float, WS_YP);
            const float* g2 = inp(I_LN2G) + (size_t)l * DM; const float* b2 = inp(I_LN2B) + (size_t)l * DM;
            const float* modn = WSP(float, WS_MOD) + (size_t)(l + 1 < NLAYER ? l + 1 : l) * 3 * NADA;
            for (int row = gw; row < M; row += NGW) { const int b = row / LT, p = row - b * LT, j = (p < CTX) ? 2 : b;
                if (!lastl) ln_row(Y + (size_t)row * DM, g2, b2, X + (size_t)row * DM, H + (size_t)row * DM, modn + (size_t)j * NADA + 1 * DM, modn + (size_t)j * NADA + 0 * DM, nullptr, lane,
                                   (p < CTX) ? YP + (size_t)(b * 256 + p) * DM : nullptr, X + (size_t)row * DM, MODL + (size_t)j * NADA + 5 * DM);
                else if (p >= CTX) ln_row(Y + (size_t)row * DM, g2, b2, nullptr, nullptr, nullptr, nullptr, outp + ((size_t)(b * SEQ + p - CTX)) * DM, lane); }
        }
        REP_END(11)
        if (!lastl) SEAM(P0 + 9);
    }
#undef IN
#undef SEAM
}

extern "C" void kernel_launch(void* const* d_in, const int* in_sizes, int n_in, void* d_out, int out_size, void* d_ws, size_t ws_size, hipStream_t stream) {
    static int grid = 0;
    if (grid == 0) {
        if (n_in != 22 || in_sizes[0] != NB * SEQ * DM || out_size != NB * SEQ * DM || ws_size < WS_END) {
            fprintf(stderr, "kernel_launch: shape mismatch: n_in %d in0 %d out %d ws %zu (need %zu)\n", n_in, n_in > 0 ? in_sizes[0] : -1, out_size, ws_size, (size_t)WS_END); grid = -1; return; }
        int dev = 0, cus = 0, per_cu = 0;
        if (hipGetDevice(&dev) != hipSuccess || hipDeviceGetAttribute(&cus, hipDeviceAttributeMultiprocessorCount, dev) != hipSuccess) { grid = -1; return; }
        if (hipFuncSetAttribute((const void*)fwd, hipFuncAttributeMaxDynamicSharedMemorySize, LDS_BYTES) != hipSuccess) { fprintf(stderr, "kernel_launch: hipFuncSetAttribute failed\n"); grid = -1; return; }
        if (hipOccupancyMaxActiveBlocksPerMultiprocessor(&per_cu, (const void*)fwd, NTHREADS, LDS_BYTES) != hipSuccess || per_cu < 1) fprintf(stderr, "kernel_launch: occupancy query reports %d\n", per_cu);
        (void)hipGetLastError();
        grid = cus;
    }
    if (grid < 0) return;
    if (hipMemsetAsync((char*)d_ws + WS_CTL, 0, CTL_ZERO_BYTES, stream) != hipSuccess) return;
    Args a{};
    for (int i = 0; i < 22; ++i) a.in[i] = (const float*)d_in[i];
    a.out = (float*)d_out; a.ws = (unsigned char*)d_ws;
    if (MK_N_LAUNCHES == 1) { a.ph_lo = 0; a.ph_hi = NPH; a.li = 0; hipLaunchKernelGGL(fwd, dim3(grid), dim3(NTHREADS), LDS_BYTES, stream, a); }
    else for (int p = 0; p < NPH; ++p) { a.ph_lo = p; a.ph_hi = p + 1; a.li = p; hipLaunchKernelGGL(fwd, dim3(grid), dim3(NTHREADS), LDS_BYTES, stream, a); }
}
```
